# Optimizing an MI355X kernel written in HIP

```python
import jax, jax.numpy as jnp
from jax import lax
import numpy as np

D_MODEL = 1024
BATCH = 8
SEQ = 2048
DEPTH = 1
DEC_BATCH = 128
DEC_SEQ = 1
PAST_LEN = 16384
PAGE_SIZE = 128

MIX_A = D_MODEL // 2
MIX_B = D_MODEL - MIX_A
HA = 4
DK_A = MIX_A // HA
DV_A = MIX_A // HA
HS_B = 64
HB = MIX_B // HS_B
CONV_W = 4
CHUNK = 64
LORA_W = 64
LORA_A = 64
RMS_EPS = 1e-6
GN_EPS = 64e-5
A_QKV = 3 * MIX_A
A_W = A_QKV + MIX_A + 2 * HA
B_W = 4 * MIX_B + LORA_W + LORA_A
P_W = A_W + B_W

kernel_name = "hymba_gdn_rwkv7_step"

F32 = jnp.float32


def rmsnorm(x, w):
    x32 = x.astype(F32)
    return x32 * lax.rsqrt(jnp.mean(x32 * x32, -1, keepdims=True) + RMS_EPS) * w.astype(F32)


def l2norm(x):
    return x * lax.rsqrt(jnp.sum(x * x, -1, keepdims=True) + 1e-12)


def short_conv(buf, u, w):
    t = u.shape[1]
    full = jnp.concatenate([buf, u], axis=1)
    out = sum(full[:, i:i + t] * w[i] for i in range(CONV_W))
    return jax.nn.silu(out), full[:, full.shape[1] - (CONV_W - 1):]


def gated_delta_chunked(q, k, v, g, beta, s0):
    bsz, t, h, dk = q.shape
    t_pad = -(-t // CHUNK) * CHUNK
    pad = t_pad - t
    padt = lambda z: jnp.pad(z, [(0, 0), (0, pad)] + [(0, 0)] * (z.ndim - 2))
    q, k, v, g, beta = (padt(z) for z in (q, k, v, g, beta))
    n = t_pad // CHUNK

    def blocks(z):
        z = z.reshape((bsz, n, CHUNK) + z.shape[2:])
        return jnp.swapaxes(jnp.moveaxis(z, 3, 2), 0, 1)

    qb, kb, vb, gb, bb = (blocks(z) for z in (q, k, v, g, beta))
    G = jnp.cumsum(gb, axis=-1)
    idx = jnp.arange(CHUNK)
    strict = idx[:, None] > idx[None, :]
    incl = idx[:, None] >= idx[None, :]
    diff = G[..., :, None] - G[..., None, :]
    decay = jnp.where(incl, jnp.exp(jnp.where(incl, diff, 0.0)), 0.0)
    kk = jnp.einsum('nbhck,nbhdk->nbhcd', kb, kb)
    amat = jnp.where(strict, bb[..., :, None] * decay * kk, 0.0) + jnp.eye(CHUNK, dtype=F32)
    rhs = jnp.concatenate([(bb * jnp.exp(G))[..., None] * kb, bb[..., None] * vb], axis=-1)
    sol = lax.linalg.triangular_solve(amat, rhs, left_side=True, lower=True, unit_diagonal=True)
    wmat, umat = sol[..., :dk], sol[..., dk:]
    qk = decay * jnp.einsum('nbhck,nbhdk->nbhcd', qb, kb)
    qg = qb * jnp.exp(G)[..., None]
    kdec = kb * jnp.exp(G[..., -1:] - G)[..., None]
    glast = jnp.exp(G[..., -1])

    def step(s, xs):
        w_c, u_c, qg_c, qk_c, kd_c, gl_c = xs
        u = u_c - jnp.einsum('bhck,bhkv->bhcv', w_c, s)
        o = jnp.einsum('bhck,bhkv->bhcv', qg_c, s) + jnp.einsum('bhcd,bhdv->bhcv', qk_c, u)
        s = gl_c[..., None, None] * s + jnp.einsum('bhck,bhcv->bhkv', kd_c, u)
        return s, o

    s, o = lax.scan(step, s0, (wmat, umat, qg, qk, kdec, glast))
    o = jnp.transpose(o, (1, 0, 3, 2, 4)).reshape(bsz, t_pad, h, -1)[:, :t]
    return o, s


def rwkv7_scan(r, w, k, v, kk, a, s0):
    def step(s, xs):
        r_t, w_t, k_t, v_t, kk_t, a_t = xs
        sa = jnp.einsum('bhvk,bhk->bhv', s, -kk_t)
        s = (s * w_t[:, :, None, :] + sa[..., None] * (kk_t * a_t)[:, :, None, :]
             + v_t[..., None] * k_t[:, :, None, :])
        return s, jnp.einsum('bhvk,bhk->bhv', s, r_t)

    xs = tuple(jnp.swapaxes(z, 0, 1) for z in (r, w, k, v, kk, a))
    s, y = lax.scan(step, s0, xs)
    return jnp.swapaxes(y, 0, 1), s


def mixer_layer(x, s_a, s_conv, s_b, s_shift, norm_w, w_in, conv_w, a_log, dt_bias, a_norm_w,
                mu, w0, w2, a0, a2, k_k, k_a, r_k, ln_w, ln_b, w_out):
    bsz, t, _ = x.shape
    xn = rmsnorm(x, norm_w).astype(x.dtype)
    proj = jnp.einsum('btd,dp->btp', xn, w_in).astype(F32)
    pa, pb = proj[..., :A_W], proj[..., A_W:]

    qkv, conv_new = short_conv(s_conv.astype(F32), pa[..., :A_QKV], conv_w.astype(F32))
    q = l2norm(qkv[..., :MIX_A].reshape(bsz, t, HA, DK_A)) * (DK_A ** -0.5)
    k = l2norm(qkv[..., MIX_A:2 * MIX_A].reshape(bsz, t, HA, DK_A))
    v = qkv[..., 2 * MIX_A:].reshape(bsz, t, HA, DV_A)
    gate_a = pa[..., A_QKV:A_QKV + MIX_A]
    beta = jax.nn.sigmoid(pa[..., A_QKV + MIX_A:A_QKV + MIX_A + HA])
    g = -jnp.exp(a_log.astype(F32)) * jax.nn.softplus(pa[..., A_QKV + MIX_A + HA:] + dt_bias.astype(F32))
    o_a, s_a_new = gated_delta_chunked(q, k, v, g, beta, s_a.astype(F32))
    o_a = rmsnorm(o_a, a_norm_w).reshape(bsz, t, MIX_A) * jax.nn.silu(gate_a)

    prev = jnp.concatenate([s_shift.astype(F32)[:, None], pb[:, :-1]], axis=1)
    xb = pb + (prev - pb) * mu.astype(F32)
    shift_new = pb[:, -1]
    hd = lambda z: z.reshape(bsz, t, HB, HS_B)
    r = xb[..., :MIX_B]
    kr = xb[..., MIX_B:2 * MIX_B]
    vr = xb[..., 2 * MIX_B:3 * MIX_B]
    gate_b = xb[..., 3 * MIX_B:4 * MIX_B]
    wd = xb[..., 4 * MIX_B:4 * MIX_B + LORA_W]
    ad = xb[..., 4 * MIX_B + LORA_W:]
    w_ll = -jax.nn.softplus(-(w0.astype(F32) + jnp.tanh(wd) @ w2.astype(F32))) - 0.5
    wdec = jnp.exp(-jnp.exp(w_ll))
    a = jax.nn.sigmoid(a0.astype(F32) + ad @ a2.astype(F32))
    kk = l2norm(hd(kr * k_k.astype(F32)))
    kmod = kr * (1.0 + (a - 1.0) * k_a.astype(F32))
    r_h, k_h, v_h = hd(r), hd(kmod), hd(vr)
    y_b, s_b_new = rwkv7_scan(r_h, hd(wdec), k_h, v_h, kk, hd(a), s_b.astype(F32))
    mean = jnp.mean(y_b, -1, keepdims=True)
    var = jnp.mean(jnp.square(y_b - mean), -1, keepdims=True)
    gn = ((y_b - mean) * lax.rsqrt(var + GN_EPS)).reshape(bsz, t, MIX_B) * ln_w.astype(F32) + ln_b.astype(F32)
    bonus = jnp.sum(r_h * k_h * r_k.astype(F32), -1, keepdims=True) * v_h
    o_b = (gn + bonus.reshape(bsz, t, MIX_B)) * jax.nn.silu(gate_b)

    mix = jnp.concatenate([o_a, o_b], axis=-1).astype(x.dtype)
    h = x + jnp.einsum('btm,md->btd', mix, w_out)
    dt = x.dtype
    return h, (s_a_new.astype(dt), conv_new.astype(dt), s_b_new.astype(dt), shift_new.astype(dt))


def setup_inputs(seed: int = 0) -> dict:
    key = jax.random.key(seed)
    ks = jax.random.split(key, 32)
    nrm = lambda i, shape, s=1.0: jax.random.normal(ks[i], shape, F32) * s
    return {
        "x_prompt": nrm(0, (BATCH, SEQ, D_MODEL)),
        "x_sample": nrm(1, (DEC_BATCH, DEC_SEQ, D_MODEL)),
        "state_a_mat": nrm(2, (DEPTH, DEC_BATCH, HA, DK_A, DV_A), 0.5),
        "state_a_conv": nrm(3, (DEPTH, DEC_BATCH, CONV_W - 1, A_QKV)),
        "state_b_mat": nrm(4, (DEPTH, DEC_BATCH, HB, HS_B, HS_B), 0.1),
        "state_b_shift": nrm(5, (DEPTH, DEC_BATCH, B_W)),
        "norm_w": 1.0 + nrm(6, (DEPTH, D_MODEL), 0.01),
        "w_in": nrm(7, (DEPTH, D_MODEL, P_W), D_MODEL ** -0.5),
        "conv_w": nrm(8, (DEPTH, CONV_W, A_QKV), CONV_W ** -0.5),
        "a_log": jnp.log(jax.random.uniform(ks[9], (DEPTH, HA), F32, 1.0, 16.0)),
        "dt_bias": nrm(10, (DEPTH, HA), 0.1),
        "a_norm_w": 1.0 + nrm(11, (DEPTH, DV_A), 0.01),
        "mu": jax.random.uniform(ks[12], (DEPTH, B_W), F32, 0.0, 1.0),
        "w0": nrm(13, (DEPTH, MIX_B), 0.5),
        "w2": nrm(14, (DEPTH, LORA_W, MIX_B), 0.5 * LORA_W ** -0.5),
        "a0": nrm(15, (DEPTH, MIX_B), 0.1),
        "a2": nrm(16, (DEPTH, LORA_A, MIX_B), LORA_A ** -0.5),
        "k_k": 0.85 + nrm(17, (DEPTH, MIX_B), 0.02),
        "k_a": 1.0 + nrm(18, (DEPTH, MIX_B), 0.02),
        "r_k": nrm(19, (DEPTH, HB, HS_B), 0.1),
        "ln_w": 1.0 + nrm(20, (DEPTH, MIX_B), 0.01),
        "ln_b": nrm(21, (DEPTH, MIX_B), 0.01),
        "w_out": nrm(22, (DEPTH, D_MODEL, D_MODEL), D_MODEL ** -0.5),
        "final_norm_w": 1.0 + nrm(23, (D_MODEL,), 0.01),
    }


def reference(x_prompt, x_sample, state_a_mat, state_a_conv, state_b_mat, state_b_shift,
              norm_w, w_in, conv_w, a_log, dt_bias, a_norm_w, mu, w0, w2, a0, a2, k_k, k_a,
              r_k, ln_w, ln_b, w_out, final_norm_w):
    hp, hs = x_prompt, x_sample
    dt = x_prompt.dtype
    p_amat, p_aconv, p_bmat, p_bshift = [], [], [], []
    s_amat, s_aconv, s_bmat, s_bshift = [], [], [], []
    for l in range(DEPTH):
        wts = (norm_w[l], w_in[l], conv_w[l], a_log[l], dt_bias[l], a_norm_w[l], mu[l], w0[l], w2[l],
               a0[l], a2[l], k_k[l], k_a[l], r_k[l], ln_w[l], ln_b[l], w_out[l])
        z_a = jnp.zeros((BATCH, HA, DK_A, DV_A), dt)
        z_c = jnp.zeros((BATCH, CONV_W - 1, A_QKV), dt)
        z_b = jnp.zeros((BATCH, HB, HS_B, HS_B), dt)
        z_s = jnp.zeros((BATCH, B_W), dt)
        hp, (pa, pc, pbm, pbs) = mixer_layer(hp, z_a, z_c, z_b, z_s, *wts)
        hs, (sa, sc, sbm, sbs) = mixer_layer(hs, state_a_mat[l], state_a_conv[l], state_b_mat[l],
                                             state_b_shift[l], *wts)
        p_amat.append(pa); p_aconv.append(pc); p_bmat.append(pbm); p_bshift.append(pbs)
        s_amat.append(sa); s_aconv.append(sc); s_bmat.append(sbm); s_bshift.append(sbs)
    y_prompt = rmsnorm(hp, final_norm_w).astype(dt)
    y_sample = rmsnorm(hs, final_norm_w).astype(dt)
    return (y_prompt, y_sample,
            jnp.stack(p_amat), jnp.stack(p_aconv), jnp.stack(p_bmat), jnp.stack(p_bshift),
            jnp.stack(s_amat), jnp.stack(s_aconv), jnp.stack(s_bmat), jnp.stack(s_bshift))
```

```cpp
#include <hip/hip_runtime.h>
#include <hip/hip_cooperative_groups.h>
#include <cstdio>
namespace cg = cooperative_groups;
namespace pg8 {
#define PG8_LAS __attribute__((address_space(3)))
typedef unsigned short bf16_t;
typedef short bf16x8 __attribute__((ext_vector_type(8)));
typedef float f32x4 __attribute__((ext_vector_type(4)));
typedef unsigned u32x4 __attribute__((ext_vector_type(4)));
constexpr int BM = 256, BK = 64, HALF = 128, HTB = HALF * BK * 2  , STAGE_BYTES = 8 * HTB, NXCD = 8, WGM = 8;

__host__ __device__ __forceinline__ int lds_byte(int r, int c) { const int st = (r >> 4) * 2 + (c >> 5), rr = r & 15, cc = c & 31, ob = rr * 64 + cc * 2; return st * 1024 + (ob ^ (((ob >> 9) & 1) << 5)); }
__host__ __device__ __forceinline__ void stage_rc(int b, int& R, int& C) { const int st = b / 1024, sb = b % 1024, swz = sb ^ (((sb >> 9) & 1) << 5); R = (st >> 1) * 16 + swz / 64; C = (st & 1) * 32 + (swz % 64) / 2; }
__host__ __device__ __forceinline__ int perm32(int rho) { const int n = rho >> 4, i = rho & 15; return 8 * (i >> 2) + 4 * n + (i & 3); }

struct Unit { int pm, pn; };
struct Gemm { const bf16_t* A; const bf16_t* Bt; int M, N, K; };

struct StaticOrder {
    int nM, nN, nwg, G, c;
    __host__ __device__ void init(int M, int N, int G_, int c_) { nM = M / BM; nN = N / BM; nwg = nM * nN; G = G_; c = c_; }
    __host__ __device__ bool next(int i, Unit& u) const {
        const long L = (long)i * G + c; if (L >= nwg) return false;
        int wgid = (int)L; { const int q = nwg / NXCD, r = nwg % NXCD, xcd = wgid % NXCD, off = wgid / NXCD; wgid = (xcd < r ? xcd * (q + 1) : r * (q + 1) + (xcd - r) * q) + off; }
        const int nig = WGM * nN, gid = wgid / nig, fm = gid * WGM, gsz = (nM - fm) < WGM ? (nM - fm) : WGM;
        u.pm = fm + ((wgid % nig) % gsz); u.pn = (wgid % nig) / gsz; return true;
    }
    __device__ __forceinline__ void a_ready(const Unit&) const {}
    __device__ __forceinline__ void done(const Unit&) const {}
};

template <class Epi, class Sched, bool STAMP = false>
__device__ __forceinline__ void gemm_phase(PG8_LAS unsigned char* lds, const Gemm g, const Sched& S, const Epi& E, unsigned long long* stamps) {
    int tid_ = threadIdx.x; asm volatile("" : "+v"(tid_));
    const int tid = tid_, wid = __builtin_amdgcn_readfirstlane(tid >> 6), lane = tid & 63, wr = wid >> 2, wc = wid & 3, fr = lane & 15, fq = lane >> 4;
    const int K = g.K, nt = K / BK;
    int ts_lo = 0, ts_hi = 0, nts = 0; const unsigned long long rt_entry = STAMP ? (unsigned long long)wall_clock64() : 0ull;
#define PG8_STAMP() do { if (STAMP && wid == 0 && nts < 64) { const unsigned long long _c = (unsigned long long)clock64(); \
        ts_lo = (lane == nts) ? (int)(unsigned)_c : ts_lo; ts_hi = (lane == nts) ? (int)(unsigned)(_c >> 32) : ts_hi; ++nts; } } while (0)
    PG8_STAMP();
    unsigned voffA[2], voffB[2];
#pragma unroll
    for (int i = 0; i < 2; ++i) { int R, C; stage_rc(tid * 16 + i * 8192, R, C); const int Rb = Epi::PERM ? ((R & ~31) + perm32(R & 31)) : R;
        voffA[i] = (unsigned)(R * K + C) * 2u; voffB[i] = (unsigned)(Rb * K + C) * 2u; }
    const size_t kstep = (size_t)(BK * 2);
    const size_t hstep = (size_t)HALF * K * 2;
    const size_t tstep = 2 * hstep;
    const unsigned ldsw = (unsigned)wid * 1024u;
    const int aoff = lds_byte(wr * 64 + fr, fq * 8), boff = lds_byte(wc * 32 + fr, fq * 8);
#define PG8_SA(b, h) (((b) * 2 + (h)) * HTB)
#define PG8_SB(b, h) ((4 + (b) * 2 + (h)) * HTB)
#define PG8_STAGE(bufoff, gbase, voff) do { _Pragma("unroll") for (int _i = 0; _i < 2; ++_i) \
        __builtin_amdgcn_global_load_lds((const unsigned*)((const char*)(gbase) + (voff)[_i]), (PG8_LAS unsigned*)(lds + (bufoff) + ldsw + _i * 8192), 16, 0, 0); } while (0)
#define PG8_LDA(dst, b, h) do { _Pragma("unroll") for (int m = 0; m < 4; ++m) _Pragma("unroll") for (int k = 0; k < 2; ++k) dst[m][k] = *(const PG8_LAS bf16x8*)(lds + PG8_SA(b, h) + aoff + m * 2048 + k * 1024); } while (0)
#define PG8_LDB(dst, b, h) do { _Pragma("unroll") for (int n = 0; n < 2; ++n) _Pragma("unroll") for (int k = 0; k < 2; ++k) dst[n][k] = *(const PG8_LAS bf16x8*)(lds + PG8_SB(b, h) + boff + n * 2048 + k * 1024); } while (0)
#define PG8_MMA(ai, bj, At, Bt) do { __builtin_amdgcn_s_setprio(1); _Pragma("unroll") for (int m = 0; m < 4; ++m) _Pragma("unroll") for (int n = 0; n < 2; ++n) _Pragma("unroll") for (int k = 0; k < 2; ++k) \
        acc[ai][bj][m][n] = __builtin_amdgcn_mfma_f32_16x16x32_bf16(Bt[n][k], At[m][k], acc[ai][bj][m][n], 0, 0, 0); __builtin_amdgcn_s_setprio(0); } while (0)
#define PG8_WAIT_V(n) asm volatile("s_waitcnt vmcnt(" #n ")" ::: "memory")
#define PG8_WAIT_L(n) asm volatile("s_waitcnt lgkmcnt(" #n ")" ::: "memory")
#define PG8_BAR __builtin_amdgcn_s_barrier()
#define PG8_SCHED __builtin_amdgcn_sched_barrier(0)
    Unit cur, nxt; int ui = 0;
    if (!S.next(0, cur)) return;
    f32x4 acc[2][2][4][2];
#pragma unroll
    for (int a = 0; a < 2; ++a)
#pragma unroll
        for (int b = 0; b < 2; ++b)
#pragma unroll
            for (int m = 0; m < 4; ++m)
#pragma unroll
                for (int n = 0; n < 2; ++n) acc[a][b][m][n] = (f32x4){0.f, 0.f, 0.f, 0.f};
    bf16x8 At[4][2], B0[2][2], B1[2][2];
    const char* cA = (const char*)g.A + (size_t)cur.pm * tstep; const char* cB = (const char*)g.Bt + (size_t)cur.pn * tstep;
    S.a_ready(cur);
    PG8_STAGE(PG8_SB(0, 0), cB, voffB); PG8_STAGE(PG8_SA(0, 0), cA, voffA); PG8_STAGE(PG8_SB(0, 1), cB + hstep, voffB); PG8_STAGE(PG8_SA(0, 1), cA + hstep, voffA);
    if (wr == 1) PG8_BAR;
    PG8_WAIT_V(4); PG8_BAR;
    PG8_STAGE(PG8_SB(1, 0), cB + kstep, voffB); PG8_STAGE(PG8_SA(1, 0), cA + kstep, voffA); PG8_STAGE(PG8_SB(1, 1), cB + hstep + kstep, voffB);
    PG8_WAIT_V(6); PG8_BAR;
    PG8_STAMP();
    for (;;) {
        const bool has_next = S.next(ui + 1, nxt);
        const char* nA = has_next ? (const char*)g.A + (size_t)nxt.pm * tstep : cA; const char* nB = has_next ? (const char*)g.Bt + (size_t)nxt.pn * tstep : cB;
        for (int t = 0; t < nt; t += 2) {
            const bool last = (t == nt - 2);
            const char* a1 = cA + (size_t)(t + 1) * kstep;
            const char* a2 = last ? nA : cA + (size_t)(t + 2) * kstep; const char* b2 = last ? nB : cB + (size_t)(t + 2) * kstep;
            const char* a3 = a2 + kstep; const char* b3 = b2 + kstep;
            if (last && has_next) S.a_ready(nxt);
            PG8_LDB(B0, 0, 0); PG8_SCHED; PG8_LDA(At, 0, 0); PG8_STAGE(PG8_SA(1, 1), a1 + hstep, voffA);
            PG8_WAIT_L(8); PG8_BAR; PG8_WAIT_L(0); PG8_MMA(0, 0, At, B0); PG8_BAR; PG8_SCHED;
            PG8_LDB(B1, 0, 1); PG8_STAGE(PG8_SB(0, 0), b2, voffB);
            PG8_BAR; PG8_WAIT_L(0); PG8_MMA(0, 1, At, B1); PG8_BAR;
            PG8_LDA(At, 0, 1); PG8_STAGE(PG8_SA(0, 0), a2, voffA);
            PG8_BAR; PG8_WAIT_L(0); PG8_MMA(1, 0, At, B0); PG8_BAR; PG8_SCHED;
            PG8_STAGE(PG8_SB(0, 1), b2 + hstep, voffB);
            PG8_WAIT_V(6); PG8_BAR; PG8_MMA(1, 1, At, B1); PG8_BAR;
            PG8_LDB(B0, 1, 0); PG8_SCHED; PG8_LDA(At, 1, 0); PG8_STAGE(PG8_SA(0, 1), a2 + hstep, voffA);
            PG8_WAIT_L(8); PG8_BAR; PG8_WAIT_L(0); PG8_MMA(0, 0, At, B0); PG8_BAR; PG8_SCHED;
            PG8_LDB(B1, 1, 1); PG8_STAGE(PG8_SB(1, 0), b3, voffB);
            PG8_BAR; PG8_WAIT_L(0); PG8_MMA(0, 1, At, B1); PG8_BAR;
            PG8_LDA(At, 1, 1); PG8_STAGE(PG8_SA(1, 0), a3, voffA);
            PG8_BAR; PG8_WAIT_L(0); PG8_MMA(1, 0, At, B0); PG8_BAR; PG8_SCHED;
            PG8_STAGE(PG8_SB(1, 1), b3 + hstep, voffB);
            PG8_WAIT_V(6); PG8_BAR; PG8_MMA(1, 1, At, B1); PG8_BAR;
        }
        PG8_STAMP();
        if constexpr (!Epi::AFTER_DRAIN) { E(acc, cur, wr, wc, fr, fq); S.done(cur); }
        PG8_STAMP();
        if (!has_next) break;
#pragma unroll
        for (int a = 0; a < 2; ++a)
#pragma unroll
            for (int b = 0; b < 2; ++b)
#pragma unroll
                for (int m = 0; m < 4; ++m)
#pragma unroll
                    for (int n = 0; n < 2; ++n) acc[a][b][m][n] = (f32x4){0.f, 0.f, 0.f, 0.f};
        cur = nxt; cA = nA; cB = nB; ++ui;
    }
    PG8_WAIT_V(0);
    if (wr == 0) PG8_BAR;
    PG8_BAR;
    if constexpr (Epi::AFTER_DRAIN) { E.fused(acc, cur, wr, wc, fr, fq, lds, wid, lane); S.done(cur); }
    PG8_STAMP();
    if (STAMP && wid == 0) { stamps[lane] = lane < nts ? (((unsigned long long)(unsigned)ts_hi << 32) | (unsigned)ts_lo) : 0ull;
        if (lane == 62) stamps[62] = rt_entry; if (lane == 63) stamps[63] = (unsigned long long)wall_clock64(); }
#undef PG8_STAMP
#undef PG8_SA
#undef PG8_SB
#undef PG8_STAGE
#undef PG8_LDA
#undef PG8_LDB
#undef PG8_MMA
#undef PG8_WAIT_V
#undef PG8_WAIT_L
#undef PG8_BAR
#undef PG8_SCHED
}
}

__device__ __forceinline__ unsigned cvt_pk_bf16(float lo, float hi) { unsigned r; asm volatile("v_cvt_pk_bf16_f32 %0, %1, %2" : "=v"(r) : "v"(lo), "v"(hi)); return r; }

using pg8::bf16_t; using pg8::bf16x8; using pg8::f32x4; using pg8::u32x4;
typedef float f32x16 __attribute__((ext_vector_type(16)));
typedef unsigned u32x2 __attribute__((ext_vector_type(2)));
typedef float f32x2 __attribute__((ext_vector_type(2)));
#define LAS __attribute__((address_space(3)))
#define DI __device__ __forceinline__
#define PARG const __attribute__((address_space(4))) Params*
#define OPAQUE(q) ({ PARG q_ = (q); asm volatile("" : "+s"(q_)); q_; })
#define LF(off)  (*(LAS float*)(lds + (off)))
#define LF2(off) (*(LAS f32x2*)(lds + (off)))
#define LF4(off) (*(LAS f32x4*)(lds + (off)))
#define LH(off)  (*(LAS unsigned short*)(lds + (off)))
#define LU1(off) (*(LAS unsigned*)(lds + (off)))
#define LU2(off) (*(LAS u32x2*)(lds + (off)))
#define LV8(off) (*(LAS bf16x8*)(lds + (off)))
#define MFMA32(a, b, c) __builtin_amdgcn_mfma_f32_32x32x16_bf16((a), (b), (c), 0, 0, 0)

constexpr int DM = 1024, NTOK = 16384, NSMP = 128, MROWS = 16512, MPAD = 16640, SEQ = 2048;
constexpr int PW = 4232, NPAD = 4352, BOFF = 2176, BW = 2176;
constexpr int NSUPER = 4, CPS = 8;
constexpr int A_UNIT = 36864, B_UNIT = 28672;
constexpr int LDS_BYTES = 131072;

struct Params {
    const float *x_prompt, *x_sample, *state_a_mat, *state_a_conv, *state_b_mat, *state_b_shift;
    const float *norm_w, *w_in, *conv_w, *a_log, *dt_bias, *a_norm_w, *mu, *w0, *w2, *a0, *a2, *k_k, *k_a, *r_k, *ln_w, *ln_b, *w_out, *final_norm_w;
    float *y, *p_amat, *p_aconv, *p_bmat, *p_bshift, *s_amat, *s_aconv, *s_bmat, *s_bshift;
    bf16_t *xb, *winT, *woutT, *proj, *scanA, *scanB;
    float *glast, *ptb, *bonus, *rowss;
};

DI unsigned short f2bf(float f) { unsigned u = __float_as_uint(f); u += 0x7fffu + ((u >> 16) & 1u); return (unsigned short)(u >> 16); }
DI float bf2f(unsigned short b) { return __uint_as_float(((unsigned)b) << 16); }
DI float bflo(unsigned u) { return __uint_as_float(u << 16); }
DI float bfhi(unsigned u) { return __uint_as_float(u & 0xffff0000u); }
DI unsigned pack2(float lo, float hi) { return (unsigned)f2bf(lo) | ((unsigned)f2bf(hi) << 16); }
DI float wave_sum(float v) {
#pragma unroll
    for (int o = 32; o; o >>= 1) v += __shfl_xor(v, o);
    return v; }
DI float half_sum32(float v) {
#pragma unroll
    for (int o = 16; o; o >>= 1) v += __shfl_xor(v, o);
    return v; }
DI int crow(int i, int h) { return (i & 3) + 8 * (i >> 2) + 4 * h; }
DI int idxA(int row, int k, int KS) { return (((row >> 5) * KS + (k >> 4)) * 64 + ((k >> 3) & 1) * 32 + (row & 31)) * 8 + (k & 7); }
DI float sigmoidf_(float x) { return 1.f / (1.f + __expf(-x)); }
DI float siluf_(float x) { return x / (1.f + __expf(-x)); }
DI float softplusf_(float x) { return x > 20.f ? x : log1pf(__expf(x)); }
DI f32x16 zero16() { f32x16 r;
#pragma unroll
    for (int i = 0; i < 16; ++i) r[i] = 0.f;
    return r; }
DI f32x16 load_ctile(const bf16_t* base, int tile, int lane) {
    const u32x4* q = (const u32x4*)(base + ((size_t)tile * 64 + lane) * 16); const u32x4 a = q[0], b = q[1]; f32x16 r;
    r[0] = bflo(a.x); r[1] = bfhi(a.x); r[2] = bflo(a.y); r[3] = bfhi(a.y); r[4] = bflo(a.z); r[5] = bfhi(a.z); r[6] = bflo(a.w); r[7] = bfhi(a.w);
    r[8] = bflo(b.x); r[9] = bfhi(b.x); r[10] = bflo(b.y); r[11] = bfhi(b.y); r[12] = bflo(b.z); r[13] = bfhi(b.z); r[14] = bflo(b.w); r[15] = bfhi(b.w);
    return r; }
DI void store_ctile(bf16_t* base, int tile, int lane, const f32x16& v) {
    u32x4* q = (u32x4*)(base + ((size_t)tile * 64 + lane) * 16); u32x4 a, b;
    a.x = pack2(v[0], v[1]); a.y = pack2(v[2], v[3]); a.z = pack2(v[4], v[5]); a.w = pack2(v[6], v[7]);
    b.x = pack2(v[8], v[9]); b.y = pack2(v[10], v[11]); b.z = pack2(v[12], v[13]); b.w = pack2(v[14], v[15]);
    q[0] = a; q[1] = b; }
DI void store_tile_T(LAS unsigned char* lds, int img, int ld, int r0, int c0, const f32x16& v, int lane) {
    const int hh = lane >> 5, l31 = lane & 31;
#pragma unroll
    for (int g = 0; g < 4; ++g) { u32x2 w; w.x = pack2(v[4 * g], v[4 * g + 1]); w.y = pack2(v[4 * g + 2], v[4 * g + 3]);
        LU2(img + ((c0 + l31) * ld + r0 + 8 * g + 4 * hh) * 2) = w; } }

struct EpiProj {
    static constexpr bool PERM = true, AFTER_DRAIN = false;
    bf16_t* O; int ldc;
    __device__ __forceinline__ void operator()(const f32x4 (&acc)[2][2][4][2], const pg8::Unit& u, int wr, int wc, int fr, int fq) const {
        const int row0 = u.pm * 256 + wr * 64 + fr, col0 = u.pn * 256 + wc * 32 + 8 * fq;
#pragma unroll
        for (int ai = 0; ai < 2; ++ai)
#pragma unroll
            for (int m = 0; m < 4; ++m) { bf16_t* rowp = O + (size_t)(row0 + ai * 128 + m * 16) * ldc + col0;
#pragma unroll
                for (int bj = 0; bj < 2; ++bj) { const f32x4 v0 = acc[ai][bj][m][0], v1 = acc[ai][bj][m][1];
                    u32x4 w; w.x = cvt_pk_bf16(v0[0], v0[1]); w.y = cvt_pk_bf16(v0[2], v0[3]); w.z = cvt_pk_bf16(v1[0], v1[1]); w.w = cvt_pk_bf16(v1[2], v1[3]);
                    *(u32x4*)(rowp + bj * 128) = w; } }
    }
};
struct EpiOut {
    static constexpr bool PERM = false, AFTER_DRAIN = false;
    const float* xp; const float* xs; float* out; float* rowss;
    __device__ __forceinline__ void operator()(const f32x4 (&acc)[2][2][4][2], const pg8::Unit& u, int wr, int wc, int fr, int fq) const {
        const int row0 = u.pm * 256 + wr * 64 + fr, col0 = u.pn * 256 + wc * 32 + 4 * fq;
#pragma unroll
        for (int ai = 0; ai < 2; ++ai)
#pragma unroll
            for (int m = 0; m < 4; ++m) { const int r = row0 + ai * 128 + m * 16; const bool valid = r < MROWS; float ss = 0.f;
                if (valid) { const float* xr = r < NTOK ? xp + (size_t)r * DM : xs + (size_t)(r - NTOK) * DM; float* orow = out + (size_t)r * DM;
#pragma unroll
                    for (int bj = 0; bj < 2; ++bj)
#pragma unroll
                        for (int n = 0; n < 2; ++n) { const int c = col0 + bj * 128 + n * 16; const f32x4 hv = *(const f32x4*)(xr + c) + acc[ai][bj][m][n];
                            *(f32x4*)(orow + c) = hv; ss += hv[0] * hv[0] + hv[1] * hv[1] + hv[2] * hv[2] + hv[3] * hv[3]; } }
                ss += __shfl_xor(ss, 16); ss += __shfl_xor(ss, 32);
                if (valid && fq == 0) rowss[(size_t)r * 16 + u.pn * 4 + wc] = ss; }
    }
};

DI void phase0(PARG p, LAS unsigned char* lds) {
    int tid_ = threadIdx.x; asm volatile("" : "+v"(tid_)); const int tid = tid_, lane = tid & 63, wid = __builtin_amdgcn_readfirstlane(tid >> 6);
    for (int row = blockIdx.x * 8 + wid; row < MPAD; row += gridDim.x * 8) {
        bf16_t* dst = p->xb + (size_t)row * DM;
        if (row >= MROWS) {
#pragma unroll
            for (int i = 0; i < 4; ++i) { u32x2 z; z.x = 0u; z.y = 0u; *(u32x2*)(dst + i * 256 + lane * 4) = z; }
        } else {
            const float* src = row < NTOK ? p->x_prompt + (size_t)row * DM : p->x_sample + (size_t)(row - NTOK) * DM;
            f32x4 v[4]; float ss = 0.f;
#pragma unroll
            for (int i = 0; i < 4; ++i) { v[i] = *(const f32x4*)(src + i * 256 + lane * 4); ss += v[i][0] * v[i][0] + v[i][1] * v[i][1] + v[i][2] * v[i][2] + v[i][3] * v[i][3]; }
            ss = wave_sum(ss); const float rs = rsqrtf(ss * (1.f / 1024.f) + 1e-6f);
#pragma unroll
            for (int i = 0; i < 4; ++i) { const f32x4 nw = *(const f32x4*)(p->norm_w + i * 256 + lane * 4); u32x2 w;
                w.x = pack2(v[i][0] * rs * nw[0], v[i][1] * rs * nw[1]); w.y = pack2(v[i][2] * rs * nw[2], v[i][3] * rs * nw[3]);
                *(u32x2*)(dst + i * 256 + lane * 4) = w; }
        }
    }
    for (int t = blockIdx.x; t < 16 * 68 + 16 * 16; t += gridDim.x) {
        const bool isout = t >= 1088; const int tt = isout ? t - 1088 : t; const int nts = isout ? 16 : 68; const int kt = tt / nts, nt = tt % nts;
        const float* W = isout ? p->w_out : p->w_in; const int ldw = isout ? 1024 : PW; bf16_t* dstT = isout ? p->woutT : p->winT;
#pragma unroll
        for (int i = 0; i < 8; ++i) { const int e = tid + 512 * i, kk = e >> 6, nn = e & 63, n = nt * 64 + nn;
            const int sc = isout ? n : (n < 2056 ? n : (n < BOFF ? -1 : n - 120));
            LF((kk * 65 + nn) * 4) = sc >= 0 ? W[(size_t)(kt * 64 + kk) * ldw + sc] : 0.f; }
        __syncthreads();
#pragma unroll
        for (int i = 0; i < 4; ++i) { const int e = tid + 512 * i, nn = e >> 5, kp = e & 31;
            *(unsigned*)(dstT + (size_t)(nt * 64 + nn) * DM + kt * 64 + 2 * kp) = pack2(LF(((2 * kp) * 65 + nn) * 4), LF(((2 * kp + 1) * 65 + nn) * 4)); }
        __syncthreads();
    }
}

DI void p2a_unit(PARG p, LAS unsigned char* lds, int b, int h, int chunk, int ua) {
    int tid_ = threadIdx.x; asm volatile("" : "+v"(tid_)); const int tid = tid_, lane = tid & 63, wid = __builtin_amdgcn_readfirstlane(tid >> 6), hh = lane >> 5, l31 = lane & 31;
    constexpr int AM = 0, GS = 17408, QB = 18432, KB = 35840, KF = 53248, VF = 86016;
    bf16_t* base = p->scanA + (size_t)ua * A_UNIT; bf16_t* Wg = base; bf16_t* QGg = base + 8192; bf16_t* KDg = base + 16384; bf16_t* QKg = base + 24576; bf16_t* Ug = base + 28672;
    const int t0 = chunk * 64;
    {
        const int cq = h * 128 + lane * 2;
        float cw[3][4][2];
#pragma unroll
        for (int g3 = 0; g3 < 3; ++g3)
#pragma unroll
            for (int i = 0; i < 4; ++i) { const float* pw = p->conv_w + i * 1536 + g3 * 512 + cq; cw[g3][i][0] = pw[0]; cw[g3][i][1] = pw[1]; }
        for (int rr = 0; rr < 8; ++rr) {
            const int i = wid * 8 + rr, t = t0 + i; float o[3][2] = {{0.f, 0.f}, {0.f, 0.f}, {0.f, 0.f}};
#pragma unroll
            for (int tap = 0; tap < 4; ++tap) { const int ts = t - 3 + tap;
                if (ts >= 0) { const bf16_t* pr = p->proj + (size_t)(b * SEQ + ts) * NPAD + cq;
#pragma unroll
                    for (int g3 = 0; g3 < 3; ++g3) { const unsigned u = *(const unsigned*)(pr + g3 * 512); o[g3][0] += bflo(u) * cw[g3][tap][0]; o[g3][1] += bfhi(u) * cw[g3][tap][1]; } } }
            float q0 = siluf_(o[0][0]), q1 = siluf_(o[0][1]), k0 = siluf_(o[1][0]), k1 = siluf_(o[1][1]); const float v0 = siluf_(o[2][0]), v1 = siluf_(o[2][1]);
            const float sq = wave_sum(q0 * q0 + q1 * q1), sk = wave_sum(k0 * k0 + k1 * k1);
            const float rq = rsqrtf(sq + 1e-12f) * 0.08838834764831845f, rk = rsqrtf(sk + 1e-12f);
            q0 *= rq; q1 *= rq; k0 *= rk; k1 *= rk;
            LU1(QB + (i * 136 + lane * 2) * 2) = pack2(q0, q1); LU1(KB + (i * 136 + lane * 2) * 2) = pack2(k0, k1);
            f32x2 kf; kf.x = k0; kf.y = k1; LF2(KF + (i * 128 + lane * 2) * 4) = kf; f32x2 vf; vf.x = v0; vf.y = v1; LF2(VF + (i * 128 + lane * 2) * 4) = vf;
            if (lane == 0) { const bf16_t* pr = p->proj + (size_t)(b * SEQ + t) * NPAD; const float beta = sigmoidf_(bf2f(pr[2048 + h]));
                const float g = -__expf(p->a_log[h]) * softplusf_(bf2f(pr[2052 + h]) + p->dt_bias[h]); LF(GS + i * 4) = g; LF(GS + 256 + i * 4) = beta; }
        }
    }
    __syncthreads();
    if (tid < 64) { float s = 0.f; for (int j = 0; j <= tid; ++j) s += LF(GS + j * 4); LF(GS + 512 + tid * 4) = s; }
    __syncthreads();
    {
        const int mat = wid >> 2, tile = wid & 3, it = tile >> 1, jt = tile & 1;
        f32x16 acc = zero16();
        const int aoff = (mat ? QB : KB) + ((it * 32 + l31) * 136 + 8 * hh) * 2, boff = KB + ((jt * 32 + l31) * 136 + 8 * hh) * 2;
#pragma unroll
        for (int s = 0; s < 8; ++s) acc = MFMA32(LV8(aoff + s * 32), LV8(boff + s * 32), acc);
        const int j = jt * 32 + l31; const float Gj = LF(GS + 512 + j * 4);
#pragma unroll
        for (int ii = 0; ii < 16; ++ii) { const int i = it * 32 + crow(ii, hh); const float Gi = LF(GS + 512 + i * 4); const float dec = __expf(fminf(Gi - Gj, 0.f));
            if (mat == 0) LF(AM + (i * 68 + j) * 4) = (j < i) ? LF(GS + 256 + i * 4) * dec * acc[ii] : 0.f;
            else QKg[idxA(i, j, 4)] = f2bf((j <= i) ? dec * acc[ii] : 0.f); }
    }
    __syncthreads();
    if (tid < 256) {
        const int c = tid; float x[64];
        LAS unsigned char* lcol = lds + (c < 128 ? KF + c * 4 : VF + (c - 128) * 4); asm volatile("" : "+v"(lcol));
        if (c < 128) {
#pragma unroll
            for (int j = 0; j < 64; ++j) x[j] = LF(GS + 256 + j * 4) * __expf(LF(GS + 512 + j * 4)) * *(LAS float*)(lcol + j * 512);
        } else {
#pragma unroll
            for (int j = 0; j < 64; ++j) x[j] = LF(GS + 256 + j * 4) * *(LAS float*)(lcol + j * 512);
        }
#pragma unroll
        for (int i = 1; i < 64; ++i) { float s = x[i];
#pragma unroll
            for (int j = 0; j < i; ++j) s -= LF(AM + (i * 68 + j) * 4) * x[j];
            x[i] = s; }
        if (c < 128) {
#pragma unroll
            for (int i = 0; i < 64; ++i) Wg[idxA(i, c, 8)] = f2bf(x[i]);
        } else { const int v = c - 128;
#pragma unroll
            for (int m = 0; m < 16; ++m) {
                const int tile = (m >> 3) * 4 + (v >> 5), hh2 = m & 1, ii0 = 4 * ((m & 7) >> 1), ln = (v & 31) + 32 * hh2;
                u32x2 w; w.x = pack2(x[4 * m], x[4 * m + 1]); w.y = pack2(x[4 * m + 2], x[4 * m + 3]);
                *(u32x2*)(Ug + ((size_t)tile * 64 + ln) * 16 + ii0) = w; }
        }
    } else {
        const int t2 = tid - 256; const float GL = LF(GS + 512 + 63 * 4);
        for (int m = 0; m < 32; ++m) { const int e = t2 + 256 * m, i = e >> 7, c = e & 127; const float Gi = LF(GS + 512 + i * 4);
            QGg[idxA(i, c, 8)] = f2bf(bf2f(LH(QB + (i * 136 + c) * 2)) * __expf(Gi));
            KDg[idxA(c, i, 4)] = f2bf(LF(KF + (i * 128 + c) * 4) * __expf(GL - Gi)); }
        if (t2 == 0) p->glast[ua] = __expf(GL);
    }
    __syncthreads();
}

DI void p2b_unit(PARG p, LAS unsigned char* lds, int b, int h, int chunk, int ub) {
    int tid_ = threadIdx.x; asm volatile("" : "+v"(tid_)); const int tid = tid_, lane = tid & 63, wid = __builtin_amdgcn_readfirstlane(tid >> 6), hh = lane >> 5, l31 = lane & 31;
    constexpr int W2T = 0, A2T = 9216, TW = 18432, AD = 27648, LAs = 36864, LPs = 53248;
    constexpr int MS = 0, MAKB = 17408, NRKB = 26624, MVF = 35840;
    constexpr int AHB = 69632, BHB = 78848, KHB = 88064, RHB = 97280, VT = 106496, KTT = 115712;
    bf16_t* base = p->scanB + (size_t)ub * B_UNIT; bf16_t* W2g = base; bf16_t* RHg = base + 4096; bf16_t* NRBg = base + 8192; bf16_t* BTg = base + 12288;
    bf16_t* U2g = base + 16384; bf16_t* Y0g = base + 20480; bf16_t* KVg = base + 24576;
#pragma unroll
    for (int m = 0; m < 8; ++m) { const int e = tid + 512 * m, l = e >> 6, ch = e & 63;
        LH(W2T + (ch * 72 + l) * 2) = f2bf(p->w2[l * 512 + h * 64 + ch]); LH(A2T + (ch * 72 + l) * 2) = f2bf(p->a2[l * 512 + h * 64 + ch]); }
    float r_[8], kr_[8], v_[8];
#pragma unroll
    for (int rr = 0; rr < 8; ++rr) {
        const int t = wid * 8 + rr, tg = chunk * 64 + t; const bf16_t* pc = p->proj + (size_t)(b * SEQ + tg) * NPAD + BOFF; const bool hp = tg > 0;
#define SHF(colB) ({ const int cb_ = (colB); const float cur_ = bf2f(pc[cb_]); const float prv_ = hp ? bf2f(pc[cb_ - NPAD]) : 0.f; cur_ + (prv_ - cur_) * p->mu[cb_]; })
        r_[rr] = SHF(h * 64 + lane); kr_[rr] = SHF(512 + h * 64 + lane); v_[rr] = SHF(1024 + h * 64 + lane);
        const float wd = SHF(2048 + lane), ad = SHF(2112 + lane);
        LH(TW + (t * 72 + lane) * 2) = f2bf(tanhf(wd)); LH(AD + (t * 72 + lane) * 2) = f2bf(ad);
    }
    __syncthreads();
    {
        const int mat = wid >> 2, tile = wid & 3, it = tile >> 1, jt = tile & 1;
        f32x16 acc = zero16();
        const int aoff = (mat ? AD : TW) + ((it * 32 + l31) * 72 + 8 * hh) * 2, boff = (mat ? A2T : W2T) + ((jt * 32 + l31) * 72 + 8 * hh) * 2;
#pragma unroll
        for (int s = 0; s < 4; ++s) acc = MFMA32(LV8(aoff + s * 32), LV8(boff + s * 32), acc);
        const int ch = jt * 32 + l31; const float bias = mat ? p->a0[h * 64 + ch] : p->w0[h * 64 + ch];
#pragma unroll
        for (int ii = 0; ii < 16; ++ii) { const int t = it * 32 + crow(ii, hh); const float z = bias + acc[ii];
            if (mat == 0) LF(LPs + (t * 64 + ch) * 4) = -__expf(-softplusf_(-z) - 0.5f);
            else LF(LAs + (t * 64 + ch) * 4) = sigmoidf_(z); }
    }
    __syncthreads();
    if (tid < 64) { float s = 0.f; for (int t = 0; t < 64; ++t) { s += LF(LPs + (t * 64 + tid) * 4); LF(LPs + (t * 64 + tid) * 4) = s; } }
    __syncthreads();
    {
        const int ch = lane; const float kkw = p->k_k[h * 64 + ch], kaw = p->k_a[h * 64 + ch], rkw = p->r_k[h * 64 + ch]; const float lpT = LF(LPs + (63 * 64 + ch) * 4);
#pragma unroll
        for (int rr = 0; rr < 8; ++rr) {
            const int t = wid * 8 + rr; const float a = LF(LAs + (t * 64 + ch) * 4), lp = LF(LPs + (t * 64 + ch) * 4); const float lpp = t > 0 ? LF(LPs + ((t - 1) * 64 + ch) * 4) : 0.f;
            const float r = r_[rr], kr = kr_[rr]; const float kkv = kr * kkw; const float ss = wave_sum(kkv * kkv); const float kk = kkv * rsqrtf(ss + 1e-12f);
            const float kmod = kr * (1.f + (a - 1.f) * kaw); const float bon = wave_sum(r * kmod * rkw);
            if (lane == 0) p->bonus[(size_t)(b * SEQ + chunk * 64 + t) * 8 + h] = bon;
            const float P = __expf(lp), Pp = __expf(lpp), Pi = __expf(-lp), Pt = __expf(lpT - lp);
            const float Ah = -kk * Pp, Bh = kk * a * Pi, Kh = kmod * Pi, Rh = r * P, Bt = kk * a * Pt, Kt = kmod * Pt;
            LH(AHB + (t * 72 + ch) * 2) = f2bf(Ah); LH(BHB + (t * 72 + ch) * 2) = f2bf(Bh); LH(KHB + (t * 72 + ch) * 2) = f2bf(Kh); LH(RHB + (t * 72 + ch) * 2) = f2bf(Rh);
            LH(VT + (ch * 72 + t) * 2) = f2bf(v_[rr]); LH(KTT + (ch * 72 + t) * 2) = f2bf(Kt);
            RHg[idxA(t, ch, 4)] = f2bf(Rh); BTg[idxA(ch, t, 4)] = f2bf(Bt);
        }
        if (wid == 7) p->ptb[(size_t)ub * 64 + ch] = __expf(lpT);
    }
    __syncthreads();
#pragma unroll
    for (int q = 0; q < 2; ++q) {
        const int tileid = 2 * wid + q, mat = tileid >> 2, tl = tileid & 3, it = tl >> 1, jt = tl & 1;
        f32x16 acc = zero16();
        const int aoff = ((mat >= 2) ? RHB : AHB) + ((it * 32 + l31) * 72 + 8 * hh) * 2, boff = ((mat & 1) ? KHB : BHB) + ((jt * 32 + l31) * 72 + 8 * hh) * 2;
#pragma unroll
        for (int s = 0; s < 4; ++s) acc = MFMA32(LV8(aoff + s * 32), LV8(boff + s * 32), acc);
        const int j = jt * 32 + l31;
#pragma unroll
        for (int ii = 0; ii < 16; ++ii) { const int i = it * 32 + crow(ii, hh); const float vs = (j < i) ? acc[ii] : 0.f, vi = (j <= i) ? acc[ii] : 0.f;
            if (mat == 0) LF(MS + (i * 68 + j) * 4) = vs;
            else if (mat == 1) LH(MAKB + (i * 72 + j) * 2) = f2bf(vs);
            else if (mat == 2) NRBg[idxA(i, j, 4)] = f2bf(vi);
            else LH(NRKB + (i * 72 + j) * 2) = f2bf(vi); }
    }
    __syncthreads();
    {
        const int mat = wid >> 2, tl = wid & 3, it = tl >> 1, jt = tl & 1;
        f32x16 acc = zero16();
        const int aoff = (mat ? NRKB : MAKB) + ((it * 32 + l31) * 72 + 8 * hh) * 2, boff = VT + ((jt * 32 + l31) * 72 + 8 * hh) * 2;
#pragma unroll
        for (int s = 0; s < 4; ++s) acc = MFMA32(LV8(aoff + s * 32), LV8(boff + s * 32), acc);
        if (mat == 0) {
#pragma unroll
            for (int ii = 0; ii < 16; ++ii) LF(MVF + ((it * 32 + crow(ii, hh)) * 64 + jt * 32 + l31) * 4) = acc[ii];
        } else store_ctile(Y0g, it * 2 + jt, lane, acc);
        if (wid < 4) { f32x16 a2 = zero16(); const int ao2 = KTT + ((it * 32 + l31) * 72 + 8 * hh) * 2;
#pragma unroll
            for (int s = 0; s < 4; ++s) a2 = MFMA32(LV8(ao2 + s * 32), LV8(boff + s * 32), a2);
            store_ctile(KVg, it * 2 + jt, lane, a2); }
    }
    __syncthreads();
    if (tid < 128) {
        const int c = tid; float x[64];
        LAS unsigned char* lcol = lds + AHB + (c & 63) * 2; asm volatile("" : "+v"(lcol));
        if (c < 64) {
#pragma unroll
            for (int j = 0; j < 64; ++j) x[j] = bf2f(*(LAS unsigned short*)(lcol + j * 144));
        } else {
#pragma unroll
            for (int j = 0; j < 64; ++j) x[j] = LF(MVF + (j * 64 + c - 64) * 4);
        }
#pragma unroll
        for (int i = 1; i < 64; ++i) { float s = x[i];
#pragma unroll
            for (int j = 0; j < i; ++j) s += LF(MS + (i * 68 + j) * 4) * x[j];
            x[i] = s; }
        if (c < 64) {
#pragma unroll
            for (int i = 0; i < 64; ++i) W2g[idxA(i, c, 4)] = f2bf(x[i]);
        } else { const int v = c - 64;
#pragma unroll
            for (int m = 0; m < 16; ++m) {
                const int tile = (m >> 3) * 2 + (v >> 5), hh2 = m & 1, ii0 = 4 * ((m & 7) >> 1), ln = (v & 31) + 32 * hh2;
                u32x2 w; w.x = pack2(x[4 * m], x[4 * m + 1]); w.y = pack2(x[4 * m + 2], x[4 * m + 3]);
                *(u32x2*)(U2g + ((size_t)tile * 64 + ln) * 16 + ii0) = w; }
        }
    }
    __syncthreads();
}

DI void scanA(PARG p, LAS unsigned char* lds, int bh, int sst) {
    int tid_ = threadIdx.x; asm volatile("" : "+v"(tid_)); const int tid = tid_, lane = tid & 63, wid = __builtin_amdgcn_readfirstlane(tid >> 6), hh = lane >> 5, l31 = lane & 31;
    const int b = bh >> 2, h = bh & 3; const int vt = wid & 3, ct = wid >> 2, kt0 = 2 * (wid >> 2);
    constexpr int ST = 0, UT = 34816, SSP = 53248;
    float* Sg = p->p_amat + (size_t)bh * 16384;
    f32x16 S0 = zero16(), S1 = zero16();
    if (sst > 0) {
#pragma unroll
        for (int ii = 0; ii < 16; ++ii) { S0[ii] = Sg[(kt0 * 32 + crow(ii, hh)) * 128 + vt * 32 + l31]; S1[ii] = Sg[((kt0 + 1) * 32 + crow(ii, hh)) * 128 + vt * 32 + l31]; }
    }
    store_tile_T(lds, ST, 136, kt0 * 32, vt * 32, S0, lane); store_tile_T(lds, ST, 136, kt0 * 32 + 32, vt * 32, S1, lane);
    __syncthreads();
    const float anw = p->a_norm_w[vt * 32 + l31];
    for (int nl = 0; nl < CPS; ++nl) {
        const int chunk = sst * CPS + nl, ua = bh * CPS + nl;
        const bf16_t* base = p->scanA + (size_t)ua * A_UNIT; const bf16_t* Wg = base; const bf16_t* QGg = base + 8192; const bf16_t* KDg = base + 16384; const bf16_t* QKg = base + 24576; const bf16_t* Ug = base + 28672;
        const float gl = p->glast[ua];
        f32x16 au = zero16(), ao = zero16();
#pragma unroll
        for (int s = 0; s < 8; ++s) { const bf16x8 bS = LV8(ST + ((vt * 32 + l31) * 136 + s * 16 + 8 * hh) * 2);
            const bf16x8 aW = *(const bf16x8*)(Wg + ((ct * 8 + s) * 64 + lane) * 8), aQ = *(const bf16x8*)(QGg + ((ct * 8 + s) * 64 + lane) * 8);
            au = MFMA32(aW, bS, au); ao = MFMA32(aQ, bS, ao); }
        { const f32x16 uc = load_ctile(Ug, ct * 4 + vt, lane);
#pragma unroll
          for (int ii = 0; ii < 16; ++ii) au[ii] = uc[ii] - au[ii]; }
        store_tile_T(lds, UT, 72, ct * 32, vt * 32, au, lane);
        __syncthreads();
#pragma unroll
        for (int ii = 0; ii < 16; ++ii) { S0[ii] *= gl; S1[ii] *= gl; }
#pragma unroll
        for (int s = 0; s < 4; ++s) { const bf16x8 bU = LV8(UT + ((vt * 32 + l31) * 72 + s * 16 + 8 * hh) * 2);
            const bf16x8 aQK = *(const bf16x8*)(QKg + ((ct * 4 + s) * 64 + lane) * 8);
            const bf16x8 aK0 = *(const bf16x8*)(KDg + ((kt0 * 4 + s) * 64 + lane) * 8), aK1 = *(const bf16x8*)(KDg + (((kt0 + 1) * 4 + s) * 64 + lane) * 8);
            ao = MFMA32(aQK, bU, ao); S0 = MFMA32(aK0, bU, S0); S1 = MFMA32(aK1, bU, S1); }
#pragma unroll
        for (int ii = 0; ii < 16; ++ii) { const float q = half_sum32(ao[ii] * ao[ii]); if (l31 == 0) LF(SSP + ((ct * 32 + crow(ii, hh)) * 4 + vt) * 4) = q; }
        store_tile_T(lds, ST, 136, kt0 * 32, vt * 32, S0, lane); store_tile_T(lds, ST, 136, kt0 * 32 + 32, vt * 32, S1, lane);
        __syncthreads();
        const int col = h * 128 + vt * 32 + l31;
#pragma unroll
        for (int ii = 0; ii < 16; ++ii) { const int c = ct * 32 + crow(ii, hh); const f32x4 pp = LF4(SSP + c * 16);
            const float rs = rsqrtf((pp[0] + pp[1] + pp[2] + pp[3]) * (1.f / 128.f) + 1e-6f); const size_t token = (size_t)b * SEQ + chunk * 64 + c;
            const float gate = bf2f(p->proj[token * NPAD + 1536 + col]);
            p->xb[token * DM + col] = f2bf(ao[ii] * rs * anw * siluf_(gate)); }
    }
#pragma unroll
    for (int ii = 0; ii < 16; ++ii) { Sg[(kt0 * 32 + crow(ii, hh)) * 128 + vt * 32 + l31] = S0[ii]; Sg[((kt0 + 1) * 32 + crow(ii, hh)) * 128 + vt * 32 + l31] = S1[ii]; }
    __syncthreads();
}

DI void scanB(PARG p, LAS unsigned char* lds, int bhp, int sst) {
    int tid_ = threadIdx.x; asm volatile("" : "+v"(tid_)); const int tid = tid_, lane = tid & 63, wid = __builtin_amdgcn_readfirstlane(tid >> 6), hh = lane >> 5, l31 = lane & 31;
    const int b = bhp >> 2, hsel = wid >> 2, h = (bhp & 3) * 2 + hsel, q = wid & 3, tt = q >> 1, vt = q & 1, kt = q >> 1;
    const int SS = hsel * 20480, CT = SS + 9216, STAT = SS + 18432;
    float* Sg = p->p_bmat + (size_t)(b * 8 + h) * 4096;
    f32x16 S = zero16();
    if (sst > 0) {
#pragma unroll
        for (int ii = 0; ii < 16; ++ii) S[ii] = Sg[(vt * 32 + l31) * 64 + kt * 32 + crow(ii, hh)];
    }
    store_tile_T(lds, SS, 72, kt * 32, vt * 32, S, lane);
    __syncthreads();
    const int cB = h * 64 + vt * 32 + l31;
    const float lnw = p->ln_w[cB], lnb = p->ln_b[cB], muv = p->mu[1024 + cB], mug = p->mu[1536 + cB];
    for (int nl = 0; nl < CPS; ++nl) {
        const int chunk = sst * CPS + nl, ub = (b * 8 + h) * CPS + nl;
        const bf16_t* base = p->scanB + (size_t)ub * B_UNIT; const bf16_t* W2g = base; const bf16_t* RHg = base + 4096; const bf16_t* NRBg = base + 8192; const bf16_t* BTg = base + 12288;
        const bf16_t* U2g = base + 16384; const bf16_t* Y0g = base + 20480; const bf16_t* KVg = base + 24576; const float* PTg = p->ptb + (size_t)ub * 64;
        f32x16 aC = load_ctile(U2g, tt * 2 + vt, lane), aY = load_ctile(Y0g, tt * 2 + vt, lane);
#pragma unroll
        for (int s = 0; s < 4; ++s) { const bf16x8 bS = LV8(SS + ((vt * 32 + l31) * 72 + s * 16 + 8 * hh) * 2);
            const bf16x8 aW = *(const bf16x8*)(W2g + ((tt * 4 + s) * 64 + lane) * 8), aR = *(const bf16x8*)(RHg + ((tt * 4 + s) * 64 + lane) * 8);
            aC = MFMA32(aW, bS, aC); aY = MFMA32(aR, bS, aY); }
        store_tile_T(lds, CT, 72, tt * 32, vt * 32, aC, lane);
        __syncthreads();
        { const f32x16 kv = load_ctile(KVg, kt * 2 + vt, lane);
#pragma unroll
          for (int ii = 0; ii < 16; ++ii) S[ii] = PTg[kt * 32 + crow(ii, hh)] * S[ii] + kv[ii]; }
#pragma unroll
        for (int s = 0; s < 4; ++s) { const bf16x8 bC = LV8(CT + ((vt * 32 + l31) * 72 + s * 16 + 8 * hh) * 2);
            const bf16x8 aN = *(const bf16x8*)(NRBg + ((tt * 4 + s) * 64 + lane) * 8), aB = *(const bf16x8*)(BTg + ((kt * 4 + s) * 64 + lane) * 8);
            aY = MFMA32(aN, bC, aY); S = MFMA32(aB, bC, S); }
#pragma unroll
        for (int ii = 0; ii < 16; ++ii) { const float s1 = half_sum32(aY[ii]), s2 = half_sum32(aY[ii] * aY[ii]);
            if (l31 == 0) { f32x2 w; w.x = s1; w.y = s2; LF2(STAT + ((tt * 32 + crow(ii, hh)) * 4 + vt * 2) * 4) = w; } }
        store_tile_T(lds, SS, 72, kt * 32, vt * 32, S, lane);
        __syncthreads();
#pragma unroll
        for (int ii = 0; ii < 16; ++ii) { const int t = tt * 32 + crow(ii, hh); const f32x4 st = LF4(STAT + t * 16);
            const float mean = (st[0] + st[2]) * (1.f / 64.f); const float var = fmaxf((st[1] + st[3]) * (1.f / 64.f) - mean * mean, 0.f); const float rstd = rsqrtf(var + 64e-5f);
            const int tg = chunk * 64 + t; const size_t row = (size_t)b * SEQ + tg; const bf16_t* pc = p->proj + row * NPAD + BOFF;
            const float gn = (aY[ii] - mean) * rstd * lnw + lnb;
            const float vcur = bf2f(pc[1024 + cB]), gcur = bf2f(pc[1536 + cB]); const float vprev = tg > 0 ? bf2f(pc[1024 + cB - NPAD]) : 0.f, gprev = tg > 0 ? bf2f(pc[1536 + cB - NPAD]) : 0.f;
            const float vv = vcur + (vprev - vcur) * muv, gt = gcur + (gprev - gcur) * mug;
            p->xb[row * DM + 512 + cB] = f2bf((gn + p->bonus[row * 8 + h] * vv) * siluf_(gt)); }
    }
#pragma unroll
    for (int ii = 0; ii < 16; ++ii) Sg[(vt * 32 + l31) * 64 + kt * 32 + crow(ii, hh)] = S[ii];
    __syncthreads();
}

DI void sample_token(PARG p, LAS unsigned char* lds, int b) {
    int tid_ = threadIdx.x; asm volatile("" : "+v"(tid_)); const int tid = tid_, lane = tid & 63, wid = __builtin_amdgcn_readfirstlane(tid >> 6);
    constexpr int QKV = 0, XBS = 1536 * 4, TWS = 3712 * 4, WDEC = 3776 * 4, ASG = 4288 * 4, KKR = 4800 * 4, KMOD = 5312 * 4, KKS = 5824 * 4, NRM = 6336 * 4, BG = 6344 * 4, BON = 6352 * 4, PART = 6360 * 4;
    const size_t R = NTOK + b; const bf16_t* pr = p->proj + R * NPAD;
#pragma unroll
    for (int m = 0; m < 3; ++m) { const int c = tid + 512 * m; const float* sc = p->state_a_conv + (size_t)b * 3 * 1536 + c; const float s0 = sc[0], s1 = sc[1536], s2 = sc[3072], cur = bf2f(pr[c]);
        const float o = s0 * p->conv_w[c] + s1 * p->conv_w[1536 + c] + s2 * p->conv_w[3072 + c] + cur * p->conv_w[4608 + c];
        LF(QKV + c * 4) = siluf_(o); float* oc = p->s_aconv + (size_t)b * 3 * 1536 + c; oc[0] = s1; oc[1536] = s2; oc[3072] = cur; }
    for (int j = tid; j < BW; j += 512) { const float cur = bf2f(pr[BOFF + j]), prev = p->state_b_shift[(size_t)b * BW + j];
        LF(XBS + j * 4) = cur + (prev - cur) * p->mu[j]; p->s_bshift[(size_t)b * BW + j] = cur; }
    __syncthreads();
    { const int hd = wid & 3, which = wid >> 2; const int o0 = which * 512 + hd * 128 + lane * 2; const float a = LF(QKV + o0 * 4), c = LF(QKV + (o0 + 1) * 4);
      const float ss = wave_sum(a * a + c * c); if (lane == 0) LF(NRM + wid * 4) = rsqrtf(ss + 1e-12f) * (which == 0 ? 0.08838834764831845f : 1.f); }
    if (tid < 4) { LF(BG + tid * 4) = sigmoidf_(bf2f(pr[2048 + tid])); LF(BG + (4 + tid) * 4) = __expf(-__expf(p->a_log[tid]) * softplusf_(bf2f(pr[2052 + tid]) + p->dt_bias[tid])); }
    if (tid < 64) LF(TWS + tid * 4) = tanhf(LF(XBS + (2048 + tid) * 4));
    __syncthreads();
    { const int cB = tid; float lw = 0.f, la = 0.f;
      for (int l = 0; l < 64; ++l) { lw += LF(TWS + l * 4) * p->w2[l * 512 + cB]; la += LF(XBS + (2112 + l) * 4) * p->a2[l * 512 + cB]; }
      const float wll = -softplusf_(-(p->w0[cB] + lw)) - 0.5f; const float a = sigmoidf_(p->a0[cB] + la); const float kr = LF(XBS + (512 + cB) * 4);
      LF(WDEC + cB * 4) = __expf(-__expf(wll)); LF(ASG + cB * 4) = a; LF(KKR + cB * 4) = kr * p->k_k[cB]; LF(KMOD + cB * 4) = kr * (1.f + (a - 1.f) * p->k_a[cB]); }
    __syncthreads();
    { const int cB = wid * 64 + lane; const float kv = LF(KKR + cB * 4); const float ss = wave_sum(kv * kv); LF(KKS + cB * 4) = kv * rsqrtf(ss + 1e-12f);
      const float bon = wave_sum(LF(XBS + cB * 4) * LF(KMOD + cB * 4) * p->r_k[cB]); if (lane == 0) LF(BON + wid * 4) = bon; }
    __syncthreads();
    {
        const int hd = tid >> 7, v = tid & 127; const float* S0 = p->state_a_mat + ((size_t)b * 4 + hd) * 16384 + v; float* S1 = p->s_amat + ((size_t)b * 4 + hd) * 16384 + v;
        const float nq = LF(NRM + hd * 4), nk = LF(NRM + (4 + hd) * 4), beta = LF(BG + hd * 4), eg = LF(BG + (4 + hd) * 4);
        float kS = 0.f, qS = 0.f, qk = 0.f;
        for (int k = 0; k < 128; ++k) { const float s = S0[k * 128], qn = LF(QKV + (hd * 128 + k) * 4) * nq, kn = LF(QKV + (512 + hd * 128 + k) * 4) * nk; kS += kn * s; qS += qn * s; qk += qn * kn; }
        const float vval = LF(QKV + (1024 + hd * 128 + v) * 4); const float u = beta * (vval - eg * kS); const float o = eg * qS + qk * u;
        for (int k = 0; k < 128; ++k) { const float kn = LF(QKV + (512 + hd * 128 + k) * 4) * nk; S1[k * 128] = eg * S0[k * 128] + kn * u; }
        const float ss = wave_sum(o * o); if (lane == 0) LF(PART + wid * 4) = ss;
        __syncthreads();
        const float rs = rsqrtf((LF(PART + (2 * hd) * 4) + LF(PART + (2 * hd + 1) * 4)) * (1.f / 128.f) + 1e-6f);
        const float gate = bf2f(pr[1536 + hd * 128 + v]);
        p->xb[R * DM + hd * 128 + v] = f2bf(o * rs * p->a_norm_w[v] * siluf_(gate));
    }
    {
        const int hd = wid, v = lane, cB = hd * 64 + v; const float* S0 = p->state_b_mat + (((size_t)b * 8 + hd) * 64 + v) * 64; float* S1 = p->s_bmat + (((size_t)b * 8 + hd) * 64 + v) * 64;
        f32x4 s[16]; float sa = 0.f;
#pragma unroll
        for (int i = 0; i < 16; ++i) { s[i] = *(const f32x4*)(S0 + 4 * i);
#pragma unroll
            for (int j = 0; j < 4; ++j) sa -= s[i][j] * LF(KKS + (hd * 64 + 4 * i + j) * 4); }
        const float vv = LF(XBS + (1024 + cB) * 4); float y = 0.f;
#pragma unroll
        for (int i = 0; i < 16; ++i) {
#pragma unroll
            for (int j = 0; j < 4; ++j) { const int k = hd * 64 + 4 * i + j; const float sn = s[i][j] * LF(WDEC + k * 4) + sa * (LF(KKS + k * 4) * LF(ASG + k * 4)) + vv * LF(KMOD + k * 4); s[i][j] = sn; y += sn * LF(XBS + k * 4); }
            *(f32x4*)(S1 + 4 * i) = s[i]; }
        const float mean = wave_sum(y) * (1.f / 64.f); const float d = y - mean; const float var = wave_sum(d * d) * (1.f / 64.f);
        const float gn = d * rsqrtf(var + 64e-5f) * p->ln_w[cB] + p->ln_b[cB];
        p->xb[R * DM + 512 + cB] = f2bf((gn + LF(BON + hd * 4) * vv) * siluf_(LF(XBS + (1536 + cB) * 4)));
    }
    __syncthreads();
}

DI void prompt_tail_states(PARG p, int b) {
    int tid_ = threadIdx.x; asm volatile("" : "+v"(tid_));
    for (int e = tid_; e < 3 * 1536; e += 512) { const int i = e / 1536, c = e % 1536; p->p_aconv[(size_t)b * 4608 + e] = bf2f(p->proj[(size_t)(b * SEQ + 2045 + i) * NPAD + c]); }
    for (int j = tid_; j < BW; j += 512) p->p_bshift[(size_t)b * BW + j] = bf2f(p->proj[(size_t)(b * SEQ + 2047) * NPAD + BOFF + j]);
}

DI void final_norm(PARG p) {
    int tid_ = threadIdx.x; asm volatile("" : "+v"(tid_)); const int lane = tid_ & 63, wid = __builtin_amdgcn_readfirstlane(tid_ >> 6);
    for (int row = blockIdx.x * 8 + wid; row < MROWS; row += gridDim.x * 8) {
        float ss = lane < 16 ? p->rowss[(size_t)row * 16 + lane] : 0.f; ss = wave_sum(ss); const float sc = rsqrtf(ss * (1.f / 1024.f) + 1e-6f);
        float* yr = p->y + (size_t)row * DM;
#pragma unroll
        for (int i = 0; i < 4; ++i) { f32x4 v = *(f32x4*)(yr + i * 256 + lane * 4); const f32x4 fw = *(const f32x4*)(p->final_norm_w + i * 256 + lane * 4);
            v[0] *= sc * fw[0]; v[1] *= sc * fw[1]; v[2] *= sc * fw[2]; v[3] *= sc * fw[3]; *(f32x4*)(yr + i * 256 + lane * 4) = v; }
    }
}

__global__ void __launch_bounds__(512, 2) hymba_step_megakernel(Params pv) {
    extern __shared__ __attribute__((aligned(16))) unsigned char shm[];
    LAS unsigned char* lds = (LAS unsigned char*)shm;
    cg::grid_group grid = cg::this_grid();
    const int G = gridDim.x, wg = blockIdx.x;
    PARG kp = (PARG)__builtin_amdgcn_kernarg_segment_ptr();
    if (pv.y == nullptr) return;

#ifndef NO_P0
    phase0(OPAQUE(kp), lds);
#endif
    grid.sync();
#ifndef NO_G1
    { PARG p = OPAQUE(kp); pg8::Gemm g; g.A = p->xb; g.Bt = p->winT; g.M = MPAD; g.N = NPAD; g.K = DM;
      pg8::StaticOrder S; S.init(MPAD, NPAD, G, wg); EpiProj E; E.O = p->proj; E.ldc = NPAD;
      pg8::gemm_phase<EpiProj, pg8::StaticOrder, false>(lds, g, S, E, nullptr); }
#endif
    grid.sync();
#pragma unroll 1
    for (int sst = 0; sst < NSUPER; ++sst) {
#ifndef NO_P2A
#pragma unroll 1
        for (int u = wg; u < 32 * CPS; u += G) { const int bh = u / CPS, nl = u % CPS; p2a_unit(OPAQUE(kp), lds, bh >> 2, bh & 3, sst * CPS + nl, u); }
#endif
#ifndef NO_P2B
#pragma unroll 1
        for (int u = wg; u < 64 * CPS; u += G) { const int bh = u / CPS, nl = u % CPS; p2b_unit(OPAQUE(kp), lds, bh >> 3, bh & 7, sst * CPS + nl, u); }
#endif
        grid.sync();
        const int nroles = sst == 0 ? 200 : 64;
#pragma unroll 1
        for (int role = wg; role < nroles; role += G) {
#ifndef NO_SA
            if (role < 32) scanA(OPAQUE(kp), lds, role, sst); else
#endif
#ifndef NO_SB
            if (role < 64) scanB(OPAQUE(kp), lds, role - 32, sst); else
#endif
#ifndef NO_SM
            if (role < 192) sample_token(OPAQUE(kp), lds, role - 64); else
#endif
            prompt_tail_states(OPAQUE(kp), role - 192);
        }
        grid.sync();
    }
#ifndef NO_G2
    { PARG p = OPAQUE(kp); pg8::Gemm g; g.A = p->xb; g.Bt = p->woutT; g.M = MPAD; g.N = DM; g.K = DM;
      pg8::StaticOrder S; S.init(MPAD, DM, G, wg); EpiOut E; E.xp = p->x_prompt; E.xs = p->x_sample; E.out = p->y; E.rowss = p->rowss;
      pg8::gemm_phase<EpiOut, pg8::StaticOrder, false>(lds, g, S, E, nullptr); }
#endif
    grid.sync();
    final_norm(OPAQUE(kp));
}

extern "C" void kernel_launch(void* const* d_in, const int* in_sizes, int n_in, void* d_out, int out_size, void* d_ws, size_t ws_size, hipStream_t stream) {
    (void)in_sizes; (void)n_in; (void)out_size; (void)ws_size;
    static int grid_blocks = 0;
    if (!grid_blocks) {
        int dev = 0, cus = 0, per_cu = 0;
        hipGetDevice(&dev);
        hipDeviceGetAttribute(&cus, hipDeviceAttributeMultiprocessorCount, dev);
        if (hipFuncSetAttribute((const void*)hymba_step_megakernel, hipFuncAttributeMaxDynamicSharedMemorySize, LDS_BYTES) != hipSuccess) fprintf(stderr, "hipFuncSetAttribute failed\n");
        if (hipOccupancyMaxActiveBlocksPerMultiprocessor(&per_cu, (const void*)hymba_step_megakernel, 512, LDS_BYTES) != hipSuccess || per_cu < 1) per_cu = 1;
        grid_blocks = cus * per_cu; if (grid_blocks > 256) grid_blocks = 256;
    }
    Params p{};
    const float* const* in = (const float* const*)d_in;
    p.x_prompt = in[0]; p.x_sample = in[1]; p.state_a_mat = in[2]; p.state_a_conv = in[3]; p.state_b_mat = in[4]; p.state_b_shift = in[5];
    p.norm_w = in[6]; p.w_in = in[7]; p.conv_w = in[8]; p.a_log = in[9]; p.dt_bias = in[10]; p.a_norm_w = in[11]; p.mu = in[12]; p.w0 = in[13]; p.w2 = in[14];
    p.a0 = in[15]; p.a2 = in[16]; p.k_k = in[17]; p.k_a = in[18]; p.r_k = in[19]; p.ln_w = in[20]; p.ln_b = in[21]; p.w_out = in[22]; p.final_norm_w = in[23];
    float* o = (float*)d_out;
    p.y = o; o += (size_t)MROWS * DM;
    p.p_amat = o; o += 8 * 4 * 128 * 128; p.p_aconv = o; o += 8 * 3 * 1536; p.p_bmat = o; o += 8 * 8 * 64 * 64; p.p_bshift = o; o += 8 * BW;
    p.s_amat = o; o += (size_t)128 * 4 * 128 * 128; p.s_aconv = o; o += 128 * 3 * 1536; p.s_bmat = o; o += (size_t)128 * 8 * 64 * 64; p.s_bshift = o;
    unsigned char* w = (unsigned char*)d_ws; size_t off = 0;
    auto take = [&](size_t bytes) { unsigned char* r = w + off; off += (bytes + 255) & ~(size_t)255; return r; };
    p.xb = (bf16_t*)take((size_t)MPAD * DM * 2); p.winT = (bf16_t*)take((size_t)NPAD * DM * 2); p.woutT = (bf16_t*)take((size_t)DM * DM * 2);
    p.proj = (bf16_t*)take((size_t)MPAD * NPAD * 2);
    p.scanA = (bf16_t*)take((size_t)32 * CPS * A_UNIT * 2); p.scanB = (bf16_t*)take((size_t)64 * CPS * B_UNIT * 2);
    p.glast = (float*)take(32 * CPS * 4); p.ptb = (float*)take((size_t)64 * CPS * 64 * 4); p.bonus = (float*)take((size_t)NTOK * 8 * 4); p.rowss = (float*)take((size_t)MPAD * 16 * 4);
    void* args[] = {&p};
    hipError_t e = hipLaunchCooperativeKernel((const void*)hymba_step_megakernel, dim3(grid_blocks), dim3(512), args, LDS_BYTES, stream);
    if (e != hipSuccess) fprintf(stderr, "cooperative launch failed: %s (grid %d)\n", hipGetErrorString(e), grid_blocks);
}
```

```cpp
#include <hip/hip_runtime.h>
#include <hip/hip_cooperative_groups.h>
#include <cstdio>
namespace cg = cooperative_groups;
namespace pg8 {
#define PG8_LAS __attribute__((address_space(3)))
typedef unsigned short bf16_t;
typedef short bf16x8 __attribute__((ext_vector_type(8)));
typedef float f32x4 __attribute__((ext_vector_type(4)));
typedef unsigned u32x4 __attribute__((ext_vector_type(4)));
constexpr int BM = 256, BK = 64, HALF = 128, HTB = HALF * BK * 2  , STAGE_BYTES = 8 * HTB, NXCD = 8, WGM = 8;

__host__ __device__ __forceinline__ int lds_byte(int r, int c) { const int st = (r >> 4) * 2 + (c >> 5), rr = r & 15, cc = c & 31, ob = rr * 64 + cc * 2; return st * 1024 + (ob ^ (((ob >> 9) & 1) << 5)); }
__host__ __device__ __forceinline__ void stage_rc(int b, int& R, int& C) { const int st = b / 1024, sb = b % 1024, swz = sb ^ (((sb >> 9) & 1) << 5); R = (st >> 1) * 16 + swz / 64; C = (st & 1) * 32 + (swz % 64) / 2; }
__host__ __device__ __forceinline__ int perm32(int rho) { const int n = rho >> 4, i = rho & 15; return 8 * (i >> 2) + 4 * n + (i & 3); }

struct Unit { int pm, pn; };
struct Gemm { const bf16_t* A; const bf16_t* Bt; int M, N, K; };

struct StaticOrder {
    int nM, nN, nwg, G, c;
    __host__ __device__ void init(int M, int N, int G_, int c_) { nM = M / BM; nN = N / BM; nwg = nM * nN; G = G_; c = c_; }
    __host__ __device__ bool next(int i, Unit& u) const {
        const long L = (long)i * G + c; if (L >= nwg) return false;
        int wgid = (int)L; { const int q = nwg / NXCD, r = nwg % NXCD, xcd = wgid % NXCD, off = wgid / NXCD; wgid = (xcd < r ? xcd * (q + 1) : r * (q + 1) + (xcd - r) * q) + off; }
        const int nig = WGM * nN, gid = wgid / nig, fm = gid * WGM, gsz = (nM - fm) < WGM ? (nM - fm) : WGM;
        u.pm = fm + ((wgid % nig) % gsz); u.pn = (wgid % nig) / gsz; return true;
    }
    __device__ __forceinline__ void a_ready(const Unit&) const {}
    __device__ __forceinline__ void done(const Unit&) const {}
};

template <class Epi, class Sched, bool STAMP = false>
__device__ __forceinline__ void gemm_phase(PG8_LAS unsigned char* lds, const Gemm g, const Sched& S, const Epi& E, unsigned long long* stamps, int tidx) {
    int tid_ = tidx; asm volatile("" : "+v"(tid_));
    const int tid = tid_, wid = __builtin_amdgcn_readfirstlane(tid >> 6), lane = tid & 63, wr = wid >> 2, wc = wid & 3, fr = lane & 15, fq = lane >> 4;
    const int K = g.K, nt = K / BK;
    int ts_lo = 0, ts_hi = 0, nts = 0; const unsigned long long rt_entry = STAMP ? (unsigned long long)wall_clock64() : 0ull;
#define PG8_STAMP() do { if (STAMP && wid == 0 && nts < 64) { const unsigned long long _c = (unsigned long long)clock64(); \
        ts_lo = (lane == nts) ? (int)(unsigned)_c : ts_lo; ts_hi = (lane == nts) ? (int)(unsigned)(_c >> 32) : ts_hi; ++nts; } } while (0)
    PG8_STAMP();
    unsigned voffA[2], voffB[2];
#pragma unroll
    for (int i = 0; i < 2; ++i) { int R, C; stage_rc(tid * 16 + i * 8192, R, C); const int Rb = Epi::PERM ? ((R & ~31) + perm32(R & 31)) : R;
        voffA[i] = (unsigned)(R * K + C) * 2u; voffB[i] = (unsigned)(Rb * K + C) * 2u; }
    const size_t kstep = (size_t)(BK * 2);
    const size_t hstep = (size_t)HALF * K * 2;
    const size_t tstep = 2 * hstep;
    const unsigned ldsw = (unsigned)wid * 1024u;
    const int aoff = lds_byte(wr * 64 + fr, fq * 8), boff = lds_byte(wc * 32 + fr, fq * 8);
#define PG8_SA(b, h) (((b) * 2 + (h)) * HTB)
#define PG8_SB(b, h) ((4 + (b) * 2 + (h)) * HTB)
#define PG8_STAGE(bufoff, gbase, voff) do { _Pragma("unroll") for (int _i = 0; _i < 2; ++_i) \
        __builtin_amdgcn_global_load_lds((const unsigned*)((const char*)(gbase) + (voff)[_i]), (PG8_LAS unsigned*)(lds + (bufoff) + ldsw + _i * 8192), 16, 0, 0); } while (0)
#define PG8_LDA(dst, b, h) do { _Pragma("unroll") for (int m = 0; m < 4; ++m) _Pragma("unroll") for (int k = 0; k < 2; ++k) dst[m][k] = *(const PG8_LAS bf16x8*)(lds + PG8_SA(b, h) + aoff + m * 2048 + k * 1024); } while (0)
#define PG8_LDB(dst, b, h) do { _Pragma("unroll") for (int n = 0; n < 2; ++n) _Pragma("unroll") for (int k = 0; k < 2; ++k) dst[n][k] = *(const PG8_LAS bf16x8*)(lds + PG8_SB(b, h) + boff + n * 2048 + k * 1024); } while (0)
#define PG8_MMA(ai, bj, At, Bt) do { __builtin_amdgcn_s_setprio(1); _Pragma("unroll") for (int m = 0; m < 4; ++m) _Pragma("unroll") for (int n = 0; n < 2; ++n) _Pragma("unroll") for (int k = 0; k < 2; ++k) \
        acc[ai][bj][m][n] = __builtin_amdgcn_mfma_f32_16x16x32_bf16(Bt[n][k], At[m][k], acc[ai][bj][m][n], 0, 0, 0); __builtin_amdgcn_s_setprio(0); } while (0)
#define PG8_WAIT_V(n) asm volatile("s_waitcnt vmcnt(" #n ")" ::: "memory")
#define PG8_WAIT_L(n) asm volatile("s_waitcnt lgkmcnt(" #n ")" ::: "memory")
#define PG8_BAR __builtin_amdgcn_s_barrier()
#define PG8_SCHED __builtin_amdgcn_sched_barrier(0)
    Unit cur, nxt; int ui = 0;
    if (!S.next(0, cur)) return;
    f32x4 acc[2][2][4][2];
#pragma unroll
    for (int a = 0; a < 2; ++a)
#pragma unroll
        for (int b = 0; b < 2; ++b)
#pragma unroll
            for (int m = 0; m < 4; ++m)
#pragma unroll
                for (int n = 0; n < 2; ++n) acc[a][b][m][n] = (f32x4){0.f, 0.f, 0.f, 0.f};
    bf16x8 At[4][2], B0[2][2], B1[2][2];
    const char* cA = (const char*)g.A + (size_t)cur.pm * tstep; const char* cB = (const char*)g.Bt + (size_t)cur.pn * tstep;
    S.a_ready(cur);
    PG8_STAGE(PG8_SB(0, 0), cB, voffB); PG8_STAGE(PG8_SA(0, 0), cA, voffA); PG8_STAGE(PG8_SB(0, 1), cB + hstep, voffB); PG8_STAGE(PG8_SA(0, 1), cA + hstep, voffA);
    if (wr == 1) PG8_BAR;
    PG8_WAIT_V(4); PG8_BAR;
    PG8_STAGE(PG8_SB(1, 0), cB + kstep, voffB); PG8_STAGE(PG8_SA(1, 0), cA + kstep, voffA); PG8_STAGE(PG8_SB(1, 1), cB + hstep + kstep, voffB);
    PG8_WAIT_V(6); PG8_BAR;
    PG8_STAMP();
    for (;;) {
        const bool has_next = S.next(ui + 1, nxt);
        const char* nA = has_next ? (const char*)g.A + (size_t)nxt.pm * tstep : cA; const char* nB = has_next ? (const char*)g.Bt + (size_t)nxt.pn * tstep : cB;
        for (int t = 0; t < nt; t += 2) {
            const bool last = (t == nt - 2);
            const char* a1 = cA + (size_t)(t + 1) * kstep;
            const char* a2 = last ? nA : cA + (size_t)(t + 2) * kstep; const char* b2 = last ? nB : cB + (size_t)(t + 2) * kstep;
            const char* a3 = a2 + kstep; const char* b3 = b2 + kstep;
            if (last && has_next) S.a_ready(nxt);
            PG8_LDB(B0, 0, 0); PG8_SCHED; PG8_LDA(At, 0, 0); PG8_STAGE(PG8_SA(1, 1), a1 + hstep, voffA);
            PG8_WAIT_L(8); PG8_BAR; PG8_WAIT_L(0); PG8_MMA(0, 0, At, B0); PG8_BAR; PG8_SCHED;
            PG8_LDB(B1, 0, 1); PG8_STAGE(PG8_SB(0, 0), b2, voffB);
            PG8_BAR; PG8_WAIT_L(0); PG8_MMA(0, 1, At, B1); PG8_BAR;
            PG8_LDA(At, 0, 1); PG8_STAGE(PG8_SA(0, 0), a2, voffA);
            PG8_BAR; PG8_WAIT_L(0); PG8_MMA(1, 0, At, B0); PG8_BAR; PG8_SCHED;
            PG8_STAGE(PG8_SB(0, 1), b2 + hstep, voffB);
            PG8_WAIT_V(6); PG8_BAR; PG8_MMA(1, 1, At, B1); PG8_BAR;
            PG8_LDB(B0, 1, 0); PG8_SCHED; PG8_LDA(At, 1, 0); PG8_STAGE(PG8_SA(0, 1), a2 + hstep, voffA);
            PG8_WAIT_L(8); PG8_BAR; PG8_WAIT_L(0); PG8_MMA(0, 0, At, B0); PG8_BAR; PG8_SCHED;
            PG8_LDB(B1, 1, 1); PG8_STAGE(PG8_SB(1, 0), b3, voffB);
            PG8_BAR; PG8_WAIT_L(0); PG8_MMA(0, 1, At, B1); PG8_BAR;
            PG8_LDA(At, 1, 1); PG8_STAGE(PG8_SA(1, 0), a3, voffA);
            PG8_BAR; PG8_WAIT_L(0); PG8_MMA(1, 0, At, B0); PG8_BAR; PG8_SCHED;
            PG8_STAGE(PG8_SB(1, 1), b3 + hstep, voffB);
            PG8_WAIT_V(6); PG8_BAR; PG8_MMA(1, 1, At, B1); PG8_BAR;
        }
        PG8_STAMP();
        if constexpr (!Epi::AFTER_DRAIN) { E(acc, cur, wr, wc, fr, fq); S.done(cur); }
        PG8_STAMP();
        if (!has_next) break;
#pragma unroll
        for (int a = 0; a < 2; ++a)
#pragma unroll
            for (int b = 0; b < 2; ++b)
#pragma unroll
                for (int m = 0; m < 4; ++m)
#pragma unroll
                    for (int n = 0; n < 2; ++n) acc[a][b][m][n] = (f32x4){0.f, 0.f, 0.f, 0.f};
        cur = nxt; cA = nA; cB = nB; ++ui;
    }
    PG8_WAIT_V(0);
    if (wr == 0) PG8_BAR;
    PG8_BAR;
    if constexpr (Epi::AFTER_DRAIN) { E.fused(acc, cur, wr, wc, fr, fq, lds, wid, lane); S.done(cur); }
    PG8_STAMP();
    if (STAMP && wid == 0) { stamps[lane] = lane < nts ? (((unsigned long long)(unsigned)ts_hi << 32) | (unsigned)ts_lo) : 0ull;
        if (lane == 62) stamps[62] = rt_entry; if (lane == 63) stamps[63] = (unsigned long long)wall_clock64(); }
#undef PG8_STAMP
#undef PG8_SA
#undef PG8_SB
#undef PG8_STAGE
#undef PG8_LDA
#undef PG8_LDB
#undef PG8_MMA
#undef PG8_WAIT_V
#undef PG8_WAIT_L
#undef PG8_BAR
#undef PG8_SCHED
}
}

__device__ __forceinline__ unsigned cvt_pk_bf16(float lo, float hi) { unsigned r; asm volatile("v_cvt_pk_bf16_f32 %0, %1, %2" : "=v"(r) : "v"(lo), "v"(hi)); return r; }
#define LAS __attribute__((address_space(3)))

#define XB_TMO      128
#define XB_XCNT(j)  (256  + 64 * (j))
#define XB_XSUB(j)  (1280 + 64 * (j))
#define XB_XGEN(j)  (2304 + 64 * (j))
#define XB_TOP      3328
#define XB_TOPGEN   3392
#define XCD_BAR_WORDS 3456
#define XB_SPIN_CAP (1u << 18)


__device__ __forceinline__ unsigned xb_ld(unsigned* p)              { return __hip_atomic_load(p, __ATOMIC_RELAXED, __HIP_MEMORY_SCOPE_AGENT); }
__device__ __forceinline__ unsigned xb_add(unsigned* p, unsigned v) { return __hip_atomic_fetch_add(p, v, __ATOMIC_RELAXED, __HIP_MEMORY_SCOPE_AGENT); }
__device__ __forceinline__ unsigned xb_xcc_id() { return (unsigned)__builtin_amdgcn_s_getreg((3 << 11) | 20) & 0xFu; }
#define XB_SPIN(cond, bar) do { unsigned _sp = 0; while (cond) { __builtin_amdgcn_s_sleep(1); \
    if ((++_sp & 255u) == 0u) { if (xb_ld(&(bar)[XB_TMO])) break; if (_sp > XB_SPIN_CAP) { atomicAdd(&(bar)[XB_TMO], 1u); break; } } } } while (0)

struct XcdBarrier {
    unsigned* bar; unsigned x;
    volatile LAS unsigned* st;
};

__device__ __forceinline__ XcdBarrier xcd_barrier_post(unsigned* bar, volatile LAS unsigned* st) {
    XcdBarrier b; b.bar = bar; b.x = xb_xcc_id(); b.st = st;
    if (threadIdx.x == 0) (void)xb_add(&bar[XB_XCNT(b.x)], 1u);
    return b;
}
__device__ __forceinline__ void xcd_barrier_complete(unsigned* bar, unsigned x, unsigned& nloc, unsigned& nx) {
    const unsigned G = gridDim.x * gridDim.y * gridDim.z;
    unsigned sum, cnt, mine, sp = 0u;
    for (;;) {
        sum = 0u; cnt = 0u; mine = 0u;
#pragma unroll
        for (unsigned j = 0; j < 16; ++j) { const unsigned c = xb_ld(&bar[XB_XCNT(j)]); sum += c; cnt += (c > 0u) ? 1u : 0u; mine = (j == x) ? c : mine; }
        if (sum == G) break;
        __builtin_amdgcn_s_sleep(1);
        if ((++sp & 255u) == 0u) { if (xb_ld(&bar[XB_TMO])) break; if (sp > XB_SPIN_CAP) { atomicAdd(&bar[XB_TMO], 1u); break; } }
    }
    nloc = mine > 0u ? mine : 1u; nx = cnt > 0u ? cnt : 1u;
}

__device__ __forceinline__ void xcd_barrier(const XcdBarrier& b, bool is_t0) {
    asm volatile("s_waitcnt vmcnt(0)" ::: "memory");
    __syncthreads();
    if (is_t0) {
        unsigned* bar = b.bar;
        __builtin_amdgcn_s_waitcnt(0);
        unsigned nloc = b.st[0], nx = b.st[1];
        if (nloc == 0u) { xcd_barrier_complete(bar, b.x, nloc, nx); b.st[0] = nloc; b.st[1] = nx; }
        const unsigned old = xb_add(&bar[XB_XSUB(b.x)], 1u);
        const unsigned gen = old / nloc;
        if (old + 1u == (gen + 1u) * nloc) {
            __builtin_amdgcn_fence(__ATOMIC_RELEASE, "agent");
            asm volatile("s_waitcnt vmcnt(0)" ::: "memory");
            const unsigned og = xb_add(&bar[XB_TOP], 1u);
            const unsigned tg = og / nx;
            if (og + 1u == (tg + 1u) * nx) xb_add(&bar[XB_TOPGEN], 1u);
            else XB_SPIN(xb_ld(&bar[XB_TOPGEN]) == tg, bar);
            __builtin_amdgcn_fence(__ATOMIC_ACQUIRE, "agent");
            xb_add(&bar[XB_XGEN(b.x)], 1u);
            asm volatile("s_waitcnt vmcnt(0)" ::: "memory");
        } else {
            XB_SPIN(xb_ld(&bar[XB_XGEN(b.x)]) == gen, bar);
            __builtin_amdgcn_fence(__ATOMIC_ACQUIRE, "agent");
            asm volatile("s_waitcnt vmcnt(0)" ::: "memory");
        }
    }
    __syncthreads();
}


using pg8::bf16_t; using pg8::bf16x8; using pg8::f32x4; using pg8::u32x4;
typedef float f32x16 __attribute__((ext_vector_type(16)));
typedef unsigned u32x2 __attribute__((ext_vector_type(2)));
typedef float f32x2 __attribute__((ext_vector_type(2)));
#define LAS __attribute__((address_space(3)))
#define DI __device__ __forceinline__
#define PARG const __attribute__((address_space(4))) Params*
#define OPAQUE(q) ({ PARG q_ = (q); asm volatile("" : "+s"(q_)); q_; })
#define LF(off)  (*(LAS float*)(lds + (off)))
#define LF2(off) (*(LAS f32x2*)(lds + (off)))
#define LF4(off) (*(LAS f32x4*)(lds + (off)))
#define LH(off)  (*(LAS unsigned short*)(lds + (off)))
#define LU1(off) (*(LAS unsigned*)(lds + (off)))
#define LU2(off) (*(LAS u32x2*)(lds + (off)))
#define LV8(off) (*(LAS bf16x8*)(lds + (off)))
#define LBAR() do { asm volatile("s_waitcnt lgkmcnt(0)" ::: "memory"); __builtin_amdgcn_s_barrier(); asm volatile("" ::: "memory"); } while (0)
#define MFMA32(a, b, c) __builtin_amdgcn_mfma_f32_32x32x16_bf16((a), (b), (c), 0, 0, 0)

constexpr int DM = 1024, NTOK = 16384, NSMP = 128, MROWS = 16512, MPAD = 16640, SEQ = 2048;
constexpr int PW = 4232, NPAD = 4352, BOFF = 2176, BW = 2176;
constexpr int NSUPER = 4, CPS = 8;
constexpr int A_UNIT = 36864, B_UNIT = 28672;
constexpr int LDS_BYTES = 163840;

struct Params {
    const float *x_prompt, *x_sample, *state_a_mat, *state_a_conv, *state_b_mat, *state_b_shift;
    const float *norm_w, *w_in, *conv_w, *a_log, *dt_bias, *a_norm_w, *mu, *w0, *w2, *a0, *a2, *k_k, *k_a, *r_k, *ln_w, *ln_b, *w_out, *final_norm_w;
    float *y, *p_amat, *p_aconv, *p_bmat, *p_bshift, *s_amat, *s_aconv, *s_bmat, *s_bshift;
    bf16_t *xb, *winT, *woutT, *proj, *scanA, *scanB;
    float *glast, *ptb, *bonus, *rowss;
    unsigned* bar;
};

typedef __bf16 bf16x2_t __attribute__((ext_vector_type(2)));
DI unsigned pack2(float lo, float hi) { f32x2 v; v.x = lo; v.y = hi; const bf16x2_t b = __builtin_convertvector(v, bf16x2_t); return __builtin_bit_cast(unsigned, b); }
DI unsigned short f2bf(float f) { return (unsigned short)(pack2(f, 0.f) & 0xffffu); }
DI float bf2f(unsigned short b) { return __uint_as_float(((unsigned)b) << 16); }
DI float bflo(unsigned u) { return __uint_as_float(u << 16); }
DI float bfhi(unsigned u) { return __uint_as_float(u & 0xffff0000u); }
#define DPPF(v, ctrl, rmask, bc) __int_as_float(__builtin_amdgcn_update_dpp(0, __float_as_int(v), (ctrl), (rmask), 0xF, (bc)))
DI float row_sum16(float v) {
    v += DPPF(v, 0xB1, 0xF, true); v += DPPF(v, 0x4E, 0xF, true); v += DPPF(v, 0x141, 0xF, true); v += DPPF(v, 0x140, 0xF, true); return v; }
DI float row_sum8(float v) {
    v += DPPF(v, 0xB1, 0xF, true); v += DPPF(v, 0x4E, 0xF, true); v += DPPF(v, 0x141, 0xF, true); return v; }
DI float wave_sum(float v) {
    v = row_sum16(v); v += DPPF(v, 0x142, 0xA, false); v += DPPF(v, 0x143, 0xC, false);
    return __int_as_float(__builtin_amdgcn_readlane(__float_as_int(v), 63)); }
DI int crow(int i, int h) { return (i & 3) + 8 * (i >> 2) + 4 * h; }
DI int idxA(int row, int k, int KS) { return (((row >> 5) * KS + (k >> 4)) * 64 + ((k >> 3) & 1) * 32 + (row & 31)) * 8 + (k & 7); }
DI float sigmoidf_(float x) { return __builtin_amdgcn_rcpf(1.f + __expf(-x)); }
DI float siluf_(float x) { return x * __builtin_amdgcn_rcpf(1.f + __expf(-x)); }
DI float softplusf_(float x) { return x > 20.f ? x : __logf(1.f + __expf(x)); }
DI float tanhf_(float x) { return 1.f - 2.f * __builtin_amdgcn_rcpf(1.f + __expf(2.f * x)); }
DI f32x16 zero16() { f32x16 r;
#pragma unroll
    for (int i = 0; i < 16; ++i) r[i] = 0.f;
    return r; }
DI f32x16 load_ctile(const bf16_t* base, int tile, int lane) {
    const u32x4* q = (const u32x4*)(base + ((size_t)tile * 64 + lane) * 16); const u32x4 a = q[0], b = q[1]; f32x16 r;
    r[0] = bflo(a.x); r[1] = bfhi(a.x); r[2] = bflo(a.y); r[3] = bfhi(a.y); r[4] = bflo(a.z); r[5] = bfhi(a.z); r[6] = bflo(a.w); r[7] = bfhi(a.w);
    r[8] = bflo(b.x); r[9] = bfhi(b.x); r[10] = bflo(b.y); r[11] = bfhi(b.y); r[12] = bflo(b.z); r[13] = bfhi(b.z); r[14] = bflo(b.w); r[15] = bfhi(b.w);
    return r; }
DI void store_ctile(bf16_t* base, int tile, int lane, const f32x16& v) {
    u32x4* q = (u32x4*)(base + ((size_t)tile * 64 + lane) * 16); u32x4 a, b;
    a.x = pack2(v[0], v[1]); a.y = pack2(v[2], v[3]); a.z = pack2(v[4], v[5]); a.w = pack2(v[6], v[7]);
    b.x = pack2(v[8], v[9]); b.y = pack2(v[10], v[11]); b.z = pack2(v[12], v[13]); b.w = pack2(v[14], v[15]);
    q[0] = a; q[1] = b; }
DI void store_tile_T(LAS unsigned char* lds, int img, int ld, int r0, int c0, const f32x16& v, int lane) {
    const int hh = lane >> 5, l31 = lane & 31;
#pragma unroll
    for (int g = 0; g < 4; ++g) { u32x2 w; w.x = pack2(v[4 * g], v[4 * g + 1]); w.y = pack2(v[4 * g + 2], v[4 * g + 3]);
        LU2(img + ((c0 + l31) * ld + r0 + 8 * g + 4 * hh) * 2) = w; } }


template <int I, int SIGN> DI void tri_row(LAS unsigned char* lds, int MOFF, f32x2 (&xv)[32], f32x4 (&an)[16]) {
    constexpr int n4 = (I + 3) >> 2; f32x4 ac[16];
#pragma unroll
    for (int q = 0; q < n4; ++q) ac[q] = an[q];
    if constexpr (I < 63) { constexpr int n4n = (I + 4) >> 2;
#pragma unroll
        for (int q = 0; q < n4n; ++q) an[q] = LF4(MOFF + ((I + 1) * 68 + 4 * q) * 4); }
    f32x2 s01 = {0.f, 0.f}, s23 = {0.f, 0.f};
#pragma unroll
    for (int q = 0; q < n4; ++q) { const f32x2 a01 = {ac[q][0], ac[q][1]}, a23 = {ac[q][2], ac[q][3]};
        s01 = __builtin_elementwise_fma(a01, xv[2 * q], s01); s23 = __builtin_elementwise_fma(a23, xv[2 * q + 1], s23); }
    const f32x2 s2 = s01 + s23; const float s = s2[0] + s2[1];
    xv[I >> 1][I & 1] = SIGN > 0 ? xv[I >> 1][I & 1] + s : xv[I >> 1][I & 1] - s;
    if constexpr (I < 63) tri_row<I + 1, SIGN>(lds, MOFF, xv, an);
}
template <int SIGN> DI void trisolve64(LAS unsigned char* lds, int MOFF, float (&x)[64]) {
    f32x4 an[16]; f32x2 xv[32];
#pragma unroll
    for (int q = 0; q < 32; ++q) { xv[q][0] = x[2 * q]; xv[q][1] = x[2 * q + 1]; }
    an[0] = LF4(MOFF + 68 * 4);
    tri_row<1, SIGN>(lds, MOFF, xv, an);
#pragma unroll
    for (int q = 0; q < 32; ++q) { x[2 * q] = xv[q][0]; x[2 * q + 1] = xv[q][1]; }
}

DI float quad_sum(float v) {
    v += __int_as_float(__builtin_amdgcn_update_dpp(0, __float_as_int(v), 0xB1, 0xF, 0xF, true));
    v += __int_as_float(__builtin_amdgcn_update_dpp(0, __float_as_int(v), 0x4E, 0xF, 0xF, true));
    return v; }
template <int I, int SIGN> DI void tri_row4p(LAS unsigned char* lrow, int s, f32x2 (&xp)[8]) {
    constexpr int n4 = (I + 3) >> 2, nm = (n4 + 3) >> 2;
    f32x2 p01 = {0.f, 0.f}, p23 = {0.f, 0.f};
#pragma unroll
    for (int m = 0; m < nm; ++m) { const f32x4 a = *(LAS f32x4*)(lrow + (I * 68 + 16 * m) * 4); const f32x2 a01 = {a[0], a[1]}, a23 = {a[2], a[3]};
        p01 = __builtin_elementwise_fma(a01, xp[2 * m], p01); p23 = __builtin_elementwise_fma(a23, xp[2 * m + 1], p23); }
    const f32x2 p2 = p01 + p23; const float tot = quad_sum(p2[0] + p2[1]);
    constexpr int own = (I >> 2) & 3, idx = (I >> 4) * 4 + (I & 3);
    const float xi = SIGN > 0 ? xp[idx >> 1][idx & 1] + tot : xp[idx >> 1][idx & 1] - tot;
    xp[idx >> 1][idx & 1] = (s == own) ? xi : xp[idx >> 1][idx & 1];
    if constexpr (I < 63) tri_row4p<I + 1, SIGN>(lrow, s, xp);
}
template <int I, int SIGN> DI void tri_row4(LAS unsigned char* lrow, int s, float (&xo)[16]) {
    static_assert(I == 1, "entry point"); f32x2 xp[8];
#pragma unroll
    for (int q = 0; q < 8; ++q) { xp[q][0] = xo[2 * q]; xp[q][1] = xo[2 * q + 1]; }
    tri_row4p<1, SIGN>(lrow, s, xp);
#pragma unroll
    for (int q = 0; q < 8; ++q) { xo[2 * q] = xp[q][0]; xo[2 * q + 1] = xp[q][1]; }
}
DI float wave_incl_scan(float v, int lane) {
    v += DPPF(v, 0x111, 0xF, true); v += DPPF(v, 0x112, 0xF, true); v += DPPF(v, 0x114, 0xF, true); v += DPPF(v, 0x118, 0xF, true);
    v += DPPF(v, 0x142, 0xA, false); v += DPPF(v, 0x143, 0xC, false);
    return v; }

struct EpiProj {
    static constexpr bool PERM = true, AFTER_DRAIN = false;
    bf16_t* O; int ldc;
    __device__ __forceinline__ void operator()(const f32x4 (&acc)[2][2][4][2], const pg8::Unit& u, int wr, int wc, int fr, int fq) const {
        const int row0 = u.pm * 256 + wr * 64 + fr, col0 = u.pn * 256 + wc * 32 + 8 * fq;
#pragma unroll
        for (int ai = 0; ai < 2; ++ai)
#pragma unroll
            for (int m = 0; m < 4; ++m) { bf16_t* rowp = O + (size_t)(row0 + ai * 128 + m * 16) * ldc + col0;
#pragma unroll
                for (int bj = 0; bj < 2; ++bj) { const f32x4 v0 = acc[ai][bj][m][0], v1 = acc[ai][bj][m][1];
                    u32x4 w; w.x = pack2(v0[0], v0[1]); w.y = pack2(v0[2], v0[3]); w.z = pack2(v1[0], v1[1]); w.w = pack2(v1[2], v1[3]);
                    *(u32x4*)(rowp + bj * 128) = w; } }
    }
};
struct EpiOut {
    static constexpr bool PERM = false, AFTER_DRAIN = false;
    const float* xp; const float* xs; float* out; float* rowss;
    __device__ __forceinline__ void operator()(const f32x4 (&acc)[2][2][4][2], const pg8::Unit& u, int wr, int wc, int fr, int fq) const {
        const int row0 = u.pm * 256 + wr * 64 + fr, col0 = u.pn * 256 + wc * 32 + 4 * fq;
#pragma unroll
        for (int ai = 0; ai < 2; ++ai)
#pragma unroll
            for (int m = 0; m < 4; ++m) { const int r = row0 + ai * 128 + m * 16; const bool valid = r < MROWS; float ss = 0.f;
                if (valid) { const float* xr = r < NTOK ? xp + (size_t)r * DM : xs + (size_t)(r - NTOK) * DM; float* orow = out + (size_t)r * DM;
#pragma unroll
                    for (int bj = 0; bj < 2; ++bj)
#pragma unroll
                        for (int n = 0; n < 2; ++n) { const int c = col0 + bj * 128 + n * 16; const f32x4 hv = *(const f32x4*)(xr + c) + acc[ai][bj][m][n];
                            *(f32x4*)(orow + c) = hv; ss += hv[0] * hv[0] + hv[1] * hv[1] + hv[2] * hv[2] + hv[3] * hv[3]; } }
                ss += __shfl_xor(ss, 16); ss += __shfl_xor(ss, 32);
                if (valid && fq == 0) rowss[(size_t)r * 16 + u.pn * 4 + wc] = ss; }
    }
};

struct OneUnit { int pm, pn;
    __device__ __forceinline__ bool next(int i, pg8::Unit& u) const { if (i > 0) return false; u.pm = pm; u.pn = pn; return true; }
    __device__ __forceinline__ void a_ready(const pg8::Unit&) const {}
    __device__ __forceinline__ void done(const pg8::Unit&) const {}
};

DI void phase0(int tidx, PARG p, LAS unsigned char* lds) {
    int tid_ = tidx; asm volatile("" : "+v"(tid_)); const int tid = tid_, lane = tid & 63, wid = __builtin_amdgcn_readfirstlane(tid >> 6);
    {
        const int stride = gridDim.x * 8; f32x4 nw[4];
#pragma unroll
        for (int i = 0; i < 4; ++i) nw[i] = *(const f32x4*)(p->norm_w + i * 256 + lane * 4);
        for (int row0 = blockIdx.x * 8 + wid; row0 < MPAD; row0 += 4 * stride) {
            f32x4 v[4][4];
#pragma unroll
            for (int r = 0; r < 4; ++r) { const int row = row0 + r * stride;
                if (row < MROWS) { const float* src = row < NTOK ? p->x_prompt + (size_t)row * DM : p->x_sample + (size_t)(row - NTOK) * DM;
#pragma unroll
                    for (int i = 0; i < 4; ++i) v[r][i] = *(const f32x4*)(src + i * 256 + lane * 4);
                } else {
#pragma unroll
                    for (int i = 0; i < 4; ++i) v[r][i] = (f32x4){0.f, 0.f, 0.f, 0.f}; } }
#pragma unroll
            for (int r = 0; r < 4; ++r) { const int row = row0 + r * stride;
                if (row < MPAD) { float ss = 0.f;
#pragma unroll
                    for (int i = 0; i < 4; ++i) ss += v[r][i][0] * v[r][i][0] + v[r][i][1] * v[r][i][1] + v[r][i][2] * v[r][i][2] + v[r][i][3] * v[r][i][3];
                    ss = wave_sum(ss); const float rs = rsqrtf(ss * (1.f / 1024.f) + 1e-6f); bf16_t* dst = p->xb + (size_t)row * DM;
#pragma unroll
                    for (int i = 0; i < 4; ++i) { u32x2 w; w.x = pack2(v[r][i][0] * rs * nw[i][0], v[r][i][1] * rs * nw[i][1]); w.y = pack2(v[r][i][2] * rs * nw[i][2], v[r][i][3] * rs * nw[i][3]);
                        *(u32x2*)(dst + i * 256 + lane * 4) = w; } } }
        }
    }
    for (int t = blockIdx.x; t < 16 * 68 + 16 * 16; t += gridDim.x) {
        const bool isout = t >= 1088; const int tt = isout ? t - 1088 : t; const int nts = isout ? 16 : 68; const int kt = tt / nts, nt = tt % nts;
        const float* W = isout ? p->w_out : p->w_in; const int ldw = isout ? 1024 : PW; bf16_t* dstT = isout ? p->woutT : p->winT;
#pragma unroll
        for (int i = 0; i < 8; ++i) { const int e = tid + 512 * i, kk = e >> 6, nn = e & 63, n = nt * 64 + nn;
            const int sc = isout ? n : (n < 2056 ? n : (n < BOFF ? -1 : n - 120));
            LF((kk * 65 + nn) * 4) = sc >= 0 ? W[(size_t)(kt * 64 + kk) * ldw + sc] : 0.f; }
        LBAR();
#pragma unroll
        for (int i = 0; i < 4; ++i) { const int e = tid + 512 * i, nn = e >> 5, kp = e & 31;
            *(unsigned*)(dstT + (size_t)(nt * 64 + nn) * DM + kt * 64 + 2 * kp) = pack2(LF(((2 * kp) * 65 + nn) * 4), LF(((2 * kp + 1) * 65 + nn) * 4)); }
        LBAR();
    }
}

DI void lds_copy_out(LAS unsigned char* lds, int lds_off, bf16_t* dst, int bytes, int tid) {
    for (int o = tid * 16; o < bytes; o += 512 * 16) *(u32x4*)((unsigned char*)dst + o) = *(LAS u32x4*)(lds + lds_off + o);
}
DI void p2a_unit(int tidx, PARG p, LAS unsigned char* lds, int b, int h, int chunk, int ua) {
    int tid_ = tidx; asm volatile("" : "+v"(tid_)); const int tid = tid_, lane = tid & 63, wid = __builtin_amdgcn_readfirstlane(tid >> 6), hh = lane >> 5, l31 = lane & 31;
    constexpr int AM = 0, GS = 17408, QB = 18432, KB = 35840, KF = 53248, VF = 86016, QKS = 118784, QGS = 126976, KDS = 143360, WS = KB, US = VF;
    bf16_t* base = p->scanA + (size_t)ua * A_UNIT;
    const int t0 = chunk * 64;
    {
        const int cq = h * 128 + lane * 2;
        float cw[3][4][2];
#pragma unroll
        for (int g3 = 0; g3 < 3; ++g3)
#pragma unroll
            for (int i = 0; i < 4; ++i) { const float* pw = p->conv_w + i * 1536 + g3 * 512 + cq; cw[g3][i][0] = pw[0]; cw[g3][i][1] = pw[1]; }
        unsigned raw[11][3];
#pragma unroll
        for (int r = 0; r < 11; ++r) { const int ts = t0 + wid * 8 - 3 + r;
            if (ts >= 0) { const bf16_t* pr = p->proj + (size_t)(b * SEQ + ts) * NPAD + cq;
#pragma unroll
                for (int g3 = 0; g3 < 3; ++g3) raw[r][g3] = *(const unsigned*)(pr + g3 * 512);
            } else { raw[r][0] = 0u; raw[r][1] = 0u; raw[r][2] = 0u; } }
        float bg = 0.f, gg = 0.f;
        if (lane < 8) { const bf16_t* pr = p->proj + (size_t)(b * SEQ + t0 + wid * 8 + lane) * NPAD; bg = sigmoidf_(bf2f(pr[2048 + h]));
            gg = -__expf(p->a_log[h]) * softplusf_(bf2f(pr[2052 + h]) + p->dt_bias[h]); }
#pragma unroll
        for (int rr = 0; rr < 8; ++rr) {
            const int i = wid * 8 + rr; float o[3][2];
#pragma unroll
            for (int g3 = 0; g3 < 3; ++g3) { o[g3][0] = 0.f; o[g3][1] = 0.f;
#pragma unroll
                for (int tap = 0; tap < 4; ++tap) { const unsigned u = raw[rr + tap][g3]; o[g3][0] += bflo(u) * cw[g3][tap][0]; o[g3][1] += bfhi(u) * cw[g3][tap][1]; } }
            float q0 = siluf_(o[0][0]), q1 = siluf_(o[0][1]), k0 = siluf_(o[1][0]), k1 = siluf_(o[1][1]); const float v0 = siluf_(o[2][0]), v1 = siluf_(o[2][1]);
            const float sq = wave_sum(q0 * q0 + q1 * q1), sk = wave_sum(k0 * k0 + k1 * k1);
            const float rq = rsqrtf(sq + 1e-12f) * 0.08838834764831845f, rk = rsqrtf(sk + 1e-12f);
            q0 *= rq; q1 *= rq; k0 *= rk; k1 *= rk;
            LU1(QB + (i * 136 + lane * 2) * 2) = pack2(q0, q1); LU1(KB + (i * 136 + lane * 2) * 2) = pack2(k0, k1);
            f32x2 kf; kf.x = k0; kf.y = k1; LF2(KF + (i * 128 + lane * 2) * 4) = kf; f32x2 vf; vf.x = v0; vf.y = v1; LF2(VF + (i * 128 + lane * 2) * 4) = vf;
        }
        if (lane < 8) { LF(GS + (wid * 8 + lane) * 4) = gg; LF(GS + 256 + (wid * 8 + lane) * 4) = bg; }
    }
    LBAR();
    if (tid < 64) { const float Gi = wave_incl_scan(LF(GS + tid * 4), lane); const float GLs = __int_as_float(__builtin_amdgcn_readlane(__float_as_int(Gi), 63));
        LF(GS + 512 + tid * 4) = Gi; LF(GS + tid * 4) = __expf(Gi); LF(GS + 768 + tid * 4) = __expf(GLs - Gi); }
    LBAR();
    {
        const int mat = wid >> 2, tile = wid & 3, it = tile >> 1, jt = tile & 1;
        f32x16 acc = zero16();
        const int aoff = (mat ? QB : KB) + ((it * 32 + l31) * 136 + 8 * hh) * 2, boff = KB + ((jt * 32 + l31) * 136 + 8 * hh) * 2;
#pragma unroll
        for (int s = 0; s < 8; ++s) acc = MFMA32(LV8(aoff + s * 32), LV8(boff + s * 32), acc);
        const int j = jt * 32 + l31; const float Gj = LF(GS + 512 + j * 4);
        if (mat == 0) {
#pragma unroll
            for (int ii = 0; ii < 16; ++ii) { const int i = it * 32 + crow(ii, hh); const float Gi = LF(GS + 512 + i * 4); const float dec = __expf(fminf(Gi - Gj, 0.f));
                const float bi = LF(GS + 256 + i * 4); LF(AM + (i * 68 + j) * 4) = (j < i) ? bi * dec * acc[ii] : 0.f; }
        } else {
#pragma unroll
            for (int ii = 0; ii < 16; ++ii) { const int i = it * 32 + crow(ii, hh); const float Gi = LF(GS + 512 + i * 4); const float dec = __expf(fminf(Gi - Gj, 0.f));
                LH(QKS + idxA(i, j, 4) * 2) = f2bf((j <= i) ? dec * acc[ii] : 0.f); }
        }
    }
    LBAR();
    float x[64];
    const int c = tid;
    if (tid < 256) {
        LAS unsigned char* lcol = lds + (c < 128 ? KF + c * 4 : VF + (c - 128) * 4); asm volatile("" : "+v"(lcol));
#pragma unroll
        for (int j = 0; j < 64; ++j) x[j] = *(LAS float*)(lcol + j * 512);
#pragma unroll
        for (int j4 = 0; j4 < 16; ++j4) { const f32x4 bv = LF4(GS + 256 + j4 * 16), gv = LF4(GS + j4 * 16);
#pragma unroll
            for (int k = 0; k < 4; ++k) x[4 * j4 + k] *= (c < 128) ? bv[k] * gv[k] : bv[k]; }
    }
    LBAR();
    if (tid < 256) {
        trisolve64<-1>(lds, AM, x);
        if (c < 128) {
#pragma unroll
            for (int i = 0; i < 64; i += 2) { const unsigned u = pack2(x[i], x[i + 1]); LH(WS + idxA(i, c, 8) * 2) = (unsigned short)u; LH(WS + idxA(i + 1, c, 8) * 2) = (unsigned short)(u >> 16); }
        } else { const int v = c - 128;
#pragma unroll
            for (int m = 0; m < 16; ++m) {
                const int tile = (m >> 3) * 4 + (v >> 5), hh2 = m & 1, ii0 = 4 * ((m & 7) >> 1), ln = (v & 31) + 32 * hh2;
                u32x2 w; w.x = pack2(x[4 * m], x[4 * m + 1]); w.y = pack2(x[4 * m + 2], x[4 * m + 3]);
                LU2(US + ((tile * 64 + ln) * 16 + ii0) * 2) = w; }
        }
    } else {
        const int t2 = tid - 256; const float GL = LF(GS + 512 + 63 * 4);
#pragma unroll
        for (int m = 0; m < 4; ++m) { const int item = t2 + 256 * m, i = item >> 4, g8 = item & 15; const float e = LF(GS + i * 4);
            const bf16x8 q8 = LV8(QB + (i * 136 + g8 * 8) * 2); u32x4 w;
            w.x = pack2(bf2f((unsigned short)q8[0]) * e, bf2f((unsigned short)q8[1]) * e); w.y = pack2(bf2f((unsigned short)q8[2]) * e, bf2f((unsigned short)q8[3]) * e);
            w.z = pack2(bf2f((unsigned short)q8[4]) * e, bf2f((unsigned short)q8[5]) * e); w.w = pack2(bf2f((unsigned short)q8[6]) * e, bf2f((unsigned short)q8[7]) * e);
            *(LAS u32x4*)(lds + QGS + idxA(i, g8 * 8, 8) * 2) = w; }
#pragma unroll
        for (int m = 0; m < 4; ++m) { const int item = t2 + 256 * m, cc = item & 127, g = item >> 7; const f32x4 e0 = LF4(GS + 768 + g * 32), e1 = LF4(GS + 768 + g * 32 + 16);
            float kv[8];
#pragma unroll
            for (int k = 0; k < 8; ++k) kv[k] = LF(KF + ((8 * g + k) * 128 + cc) * 4);
            u32x4 w; w.x = pack2(kv[0] * e0[0], kv[1] * e0[1]); w.y = pack2(kv[2] * e0[2], kv[3] * e0[3]); w.z = pack2(kv[4] * e1[0], kv[5] * e1[1]); w.w = pack2(kv[6] * e1[2], kv[7] * e1[3]);
            *(LAS u32x4*)(lds + KDS + idxA(cc, 8 * g, 4) * 2) = w; }
        if (t2 == 0) p->glast[ua] = __expf(GL);
    }
    LBAR();
    lds_copy_out(lds, WS, base, 16384, tid); lds_copy_out(lds, US, base + 8192, 16384, tid); lds_copy_out(lds, QKS, base + 16384, 40960, tid);
    LBAR();
}

DI void p2b_unit(int tidx, PARG p, LAS unsigned char* lds, int b, int h, int chunk, int ub) {
    int tid_ = tidx; asm volatile("" : "+v"(tid_)); const int tid = tid_, lane = tid & 63, wid = __builtin_amdgcn_readfirstlane(tid >> 6), hh = lane >> 5, l31 = lane & 31;
    constexpr int W2T = 0, A2T = 9216, TW = 18432, AD = 27648, LAs = 36864, LPs = 53248;
    constexpr int MS = 0, MAKB = 17408, NRKB = 26624, MVF = 35840;
    constexpr int AHB = 69632, BHB = 78848, KHB = 88064, RHB = 97280, VT = 106496, KTT = 115712;
    constexpr int RHS = 124928, BTS = 133120, NRBS = 141312, W2S = RHS, U2S = BTS, AHT = 149504, MVT = 35840, TIA = 45056;
    bf16_t* base = p->scanB + (size_t)ub * B_UNIT; bf16_t* Y0g = base + 20480; bf16_t* KVg = base + 24576;
#pragma unroll
    for (int m = 0; m < 8; ++m) { const int e = tid + 512 * m, l = e >> 6, ch = e & 63;
        LH(W2T + (ch * 72 + l) * 2) = f2bf(p->w2[l * 512 + h * 64 + ch]); LH(A2T + (ch * 72 + l) * 2) = f2bf(p->a2[l * 512 + h * 64 + ch]); }
    float r_[8], kr_[8], v_[8];
    {
        const int cols[5] = {h * 64 + lane, 512 + h * 64 + lane, 1024 + h * 64 + lane, 2048 + lane, 2112 + lane};
        float mu5[5]; unsigned short raw[9][5];
#pragma unroll
        for (int q = 0; q < 5; ++q) mu5[q] = p->mu[cols[q]];
#pragma unroll
        for (int r = 0; r < 9; ++r) { const int tg = chunk * 64 + wid * 8 - 1 + r;
            if (tg >= 0) { const bf16_t* pc = p->proj + (size_t)(b * SEQ + tg) * NPAD + BOFF;
#pragma unroll
                for (int q = 0; q < 5; ++q) raw[r][q] = pc[cols[q]];
            } else {
#pragma unroll
                for (int q = 0; q < 5; ++q) raw[r][q] = 0; } }
#pragma unroll
        for (int rr = 0; rr < 8; ++rr) { const int t = wid * 8 + rr; float sh[5];
#pragma unroll
            for (int q = 0; q < 5; ++q) { const float cur = bf2f(raw[rr + 1][q]), prv = bf2f(raw[rr][q]); sh[q] = cur + (prv - cur) * mu5[q]; }
            r_[rr] = sh[0]; kr_[rr] = sh[1]; v_[rr] = sh[2];
            LH(TW + (t * 72 + lane) * 2) = f2bf(tanhf_(sh[3])); LH(AD + (t * 72 + lane) * 2) = f2bf(sh[4]); }
    }
    LBAR();
    {
        const int mat = wid >> 2, tile = wid & 3, it = tile >> 1, jt = tile & 1;
        f32x16 acc = zero16();
        const int aoff = (mat ? AD : TW) + ((it * 32 + l31) * 72 + 8 * hh) * 2, boff = (mat ? A2T : W2T) + ((jt * 32 + l31) * 72 + 8 * hh) * 2;
#pragma unroll
        for (int s = 0; s < 4; ++s) acc = MFMA32(LV8(aoff + s * 32), LV8(boff + s * 32), acc);
        const int ch = jt * 32 + l31; const float bias = mat ? p->a0[h * 64 + ch] : p->w0[h * 64 + ch];
        const float ofac = mat ? 1.f : -0.6065306597126334f; const int obase = mat ? LAs : LPs;
#pragma unroll
        for (int ii = 0; ii < 16; ++ii) { const int t = it * 32 + crow(ii, hh); const float z = bias + acc[ii];
            LF(obase + (t * 64 + ch) * 4) = ofac * sigmoidf_(z); }
    }
    LBAR();
#pragma unroll
    for (int q = 0; q < 8; ++q) { const int ch = wid * 8 + q; LF(LPs + (lane * 64 + ch) * 4) = wave_incl_scan(LF(LPs + (lane * 64 + ch) * 4), lane); }
    LBAR();
    {
        const int ch = lane; const float kkw = p->k_k[h * 64 + ch], kaw = p->k_a[h * 64 + ch], rkw = p->r_k[h * 64 + ch]; const float lpT = LF(LPs + (63 * 64 + ch) * 4); const float PT = __expf(lpT); float Pprev = 1.f;
#pragma unroll
        for (int rp = 0; rp < 4; ++rp) {
            const int t = wid * 8 + 2 * rp;
            f32x2 a, lp, r, kr, vv; a[0] = LF(LAs + (t * 64 + ch) * 4); a[1] = LF(LAs + ((t + 1) * 64 + ch) * 4); lp[0] = LF(LPs + (t * 64 + ch) * 4); lp[1] = LF(LPs + ((t + 1) * 64 + ch) * 4);
            r[0] = r_[2 * rp]; r[1] = r_[2 * rp + 1]; kr[0] = kr_[2 * rp]; kr[1] = kr_[2 * rp + 1]; vv[0] = v_[2 * rp]; vv[1] = v_[2 * rp + 1];
            const f32x2 kkv = kr * kkw, sq = kkv * kkv; f32x2 rs; rs[0] = rsqrtf(wave_sum(sq[0]) + 1e-12f); rs[1] = rsqrtf(wave_sum(sq[1]) + 1e-12f);
            const f32x2 kk = kkv * rs, kmod = kr * ((a - 1.f) * kaw + 1.f), bw = r * kmod * rkw;
            const float bon0 = wave_sum(bw[0]), bon1 = wave_sum(bw[1]);
            if (lane == 0) { float* bp = p->bonus + (size_t)(b * SEQ + chunk * 64 + t) * 8 + h; bp[0] = bon0; bp[8] = bon1; }
            f32x2 P, Pi; P[0] = __expf(lp[0]); P[1] = __expf(lp[1]); Pi[0] = __builtin_amdgcn_rcpf(P[0]); Pi[1] = __builtin_amdgcn_rcpf(P[1]);
            f32x2 Pp; Pp[0] = rp == 0 ? __expf(t > 0 ? LF(LPs + ((t - 1) * 64 + ch) * 4) : 0.f) : Pprev; Pp[1] = P[0]; Pprev = P[1];
            const f32x2 Pt = Pi * PT, ka = kk * a, Ah = -(kk * Pp), Bh = ka * Pi, Kh = kmod * Pi, Rh = r * P, Bt = ka * Pt, Kt = kmod * Pt;
            const unsigned uA = pack2(Ah[0], Ah[1]), uB = pack2(Bh[0], Bh[1]), uK = pack2(Kh[0], Kh[1]), uR = pack2(Rh[0], Rh[1]);
            LH(AHB + (t * 72 + ch) * 2) = (unsigned short)uA; LH(AHB + ((t + 1) * 72 + ch) * 2) = (unsigned short)(uA >> 16);
            LH(BHB + (t * 72 + ch) * 2) = (unsigned short)uB; LH(BHB + ((t + 1) * 72 + ch) * 2) = (unsigned short)(uB >> 16);
            LH(KHB + (t * 72 + ch) * 2) = (unsigned short)uK; LH(KHB + ((t + 1) * 72 + ch) * 2) = (unsigned short)(uK >> 16);
            LH(RHB + (t * 72 + ch) * 2) = (unsigned short)uR; LH(RHB + ((t + 1) * 72 + ch) * 2) = (unsigned short)(uR >> 16);
            LH(RHS + idxA(t, ch, 4) * 2) = (unsigned short)uR; LH(RHS + idxA(t + 1, ch, 4) * 2) = (unsigned short)(uR >> 16);
            LU1(VT + (ch * 72 + t) * 2) = pack2(vv[0], vv[1]); LU1(KTT + (ch * 72 + t) * 2) = pack2(Kt[0], Kt[1]); LU1(AHT + (ch * 72 + t) * 2) = uA;
            LU1(BTS + idxA(ch, t, 4) * 2) = pack2(Bt[0], Bt[1]);
        }
        if (wid == 7) p->ptb[(size_t)ub * 64 + ch] = PT;
    }
    LBAR();
#pragma unroll
    for (int q = 0; q < 2; ++q) {
        const int tileid = 2 * wid + q, mat = tileid >> 2, tl = tileid & 3, it = tl >> 1, jt = tl & 1;
        f32x16 acc = zero16();
        const int aoff = ((mat >= 2) ? RHB : AHB) + ((it * 32 + l31) * 72 + 8 * hh) * 2, boff = ((mat & 1) ? KHB : BHB) + ((jt * 32 + l31) * 72 + 8 * hh) * 2;
#pragma unroll
        for (int s = 0; s < 4; ++s) acc = MFMA32(LV8(aoff + s * 32), LV8(boff + s * 32), acc);
        const int j = jt * 32 + l31;
        if (mat == 0) {
#pragma unroll
            for (int ii = 0; ii < 16; ++ii) { const int i = it * 32 + crow(ii, hh); LF(MS + (i * 68 + j) * 4) = (j < i) ? acc[ii] : 0.f; }
        } else if (mat == 1) {
#pragma unroll
            for (int ii = 0; ii < 16; ++ii) { const int i = it * 32 + crow(ii, hh); LH(MAKB + (i * 72 + j) * 2) = f2bf((j < i) ? acc[ii] : 0.f); }
        } else if (mat == 2) {
#pragma unroll
            for (int ii = 0; ii < 16; ++ii) { const int i = it * 32 + crow(ii, hh); LH(NRBS + idxA(i, j, 4) * 2) = f2bf((j <= i) ? acc[ii] : 0.f); }
        } else {
#pragma unroll
            for (int ii = 0; ii < 16; ++ii) { const int i = it * 32 + crow(ii, hh); LH(NRKB + (i * 72 + j) * 2) = f2bf((j <= i) ? acc[ii] : 0.f); }
        }
    }
    LBAR();
    lds_copy_out(lds, RHS, base, 24576, tid);
    {
        const int mat = wid >> 2, tl = wid & 3, it = tl >> 1, jt = tl & 1;
        f32x16 acc = zero16();
        const int aoff = (mat ? NRKB : MAKB) + ((it * 32 + l31) * 72 + 8 * hh) * 2, boff = VT + ((jt * 32 + l31) * 72 + 8 * hh) * 2;
#pragma unroll
        for (int s = 0; s < 4; ++s) acc = MFMA32(LV8(aoff + s * 32), LV8(boff + s * 32), acc);
        if (mat == 0) store_tile_T(lds, MVT, 72, it * 32, jt * 32, acc, lane);
        else store_ctile(Y0g, it * 2 + jt, lane, acc);
        if (wid < 4) { f32x16 a2 = zero16(); const int ao2 = KTT + ((it * 32 + l31) * 72 + 8 * hh) * 2;
#pragma unroll
            for (int s = 0; s < 4; ++s) a2 = MFMA32(LV8(ao2 + s * 32), LV8(boff + s * 32), a2);
            store_ctile(KVg, it * 2 + jt, lane, a2); }
    }
    LBAR();
    if (tid < 256) {
        const int c = tid >> 2, s = tid & 3; float xo[16];
#pragma unroll
        for (int k = 0; k < 16; ++k) xo[k] = (16 * (k >> 2) + 4 * s + (k & 3) == c) ? 1.f : 0.f;
        LAS unsigned char* lrow = lds + MS + 16 * s; asm volatile("" : "+v"(lrow));
        tri_row4<1, 1>(lrow, s, xo);
#pragma unroll
        for (int k = 0; k < 16; k += 2) { const unsigned u = pack2(xo[k], xo[k + 1]); const int j0 = 16 * (k >> 2) + 4 * s + (k & 3);
            LH(TIA + (j0 * 72 + c) * 2) = (unsigned short)u; LH(TIA + ((j0 + 1) * 72 + c) * 2) = (unsigned short)(u >> 16); }
    }
    LBAR();
    {
        const int mat = wid >> 2, tl = wid & 3, it = tl >> 1, jt = tl & 1;
        f32x16 acc = zero16();
        const int aoff = TIA + ((it * 32 + l31) * 72 + 8 * hh) * 2, boff = (mat ? MVT : AHT) + ((jt * 32 + l31) * 72 + 8 * hh) * 2;
#pragma unroll
        for (int s = 0; s < 4; ++s) acc = MFMA32(LV8(aoff + s * 32), LV8(boff + s * 32), acc);
        if (mat == 0) {
#pragma unroll
            for (int ii = 0; ii < 16; ++ii) LH(W2S + idxA(it * 32 + crow(ii, hh), jt * 32 + l31, 4) * 2) = f2bf(acc[ii]);
        } else { u32x4 a, b2;
            a.x = pack2(acc[0], acc[1]); a.y = pack2(acc[2], acc[3]); a.z = pack2(acc[4], acc[5]); a.w = pack2(acc[6], acc[7]);
            b2.x = pack2(acc[8], acc[9]); b2.y = pack2(acc[10], acc[11]); b2.z = pack2(acc[12], acc[13]); b2.w = pack2(acc[14], acc[15]);
            *(LAS u32x4*)(lds + U2S + ((it * 2 + jt) * 64 + lane) * 32) = a; *(LAS u32x4*)(lds + U2S + ((it * 2 + jt) * 64 + lane) * 32 + 16) = b2; }
    }
    LBAR();
    lds_copy_out(lds, W2S, base + 12288, 16384, tid);
    LBAR();
}

DI void dma_pieces(LAS unsigned char* lds, int lds_off, const bf16_t* g, int first, int n, int w, int nw, int lane) {
    for (int q = first + w; q < first + n; q += nw)
        __builtin_amdgcn_global_load_lds((const unsigned*)((const char*)g + q * 1024 + lane * 16), (LAS unsigned*)(lds + lds_off + q * 1024), 16, 0, 0);
}
DI void dma_one(LAS unsigned char* lds, int lds_byte, const void* gbyte, int lane) {
    __builtin_amdgcn_global_load_lds((const unsigned*)((const char*)gbyte + lane * 16), (LAS unsigned*)(lds + lds_byte), 16, 0, 0);
}
DI f32x16 expand16(const u32x4& a, const u32x4& b) { f32x16 r;
    r[0] = bflo(a.x); r[1] = bfhi(a.x); r[2] = bflo(a.y); r[3] = bfhi(a.y); r[4] = bflo(a.z); r[5] = bfhi(a.z); r[6] = bflo(a.w); r[7] = bfhi(a.w);
    r[8] = bflo(b.x); r[9] = bfhi(b.x); r[10] = bflo(b.y); r[11] = bfhi(b.y); r[12] = bflo(b.z); r[13] = bfhi(b.z); r[14] = bflo(b.w); r[15] = bfhi(b.w);
    return r; }
#define WAIT_VM0() asm volatile("s_waitcnt vmcnt(0)" ::: "memory")
#define WAIT_VM4() asm volatile("s_waitcnt vmcnt(4)" ::: "memory")
#define MEMBAR() asm volatile("" ::: "memory")

DI void scanA(int tidx, PARG p, LAS unsigned char* lds, int bh, int sst, bool dry = false) {
    int tid_ = tidx; asm volatile("" : "+v"(tid_)); const int tid = tid_, lane = tid & 63, wid = __builtin_amdgcn_readfirstlane(tid >> 6), hh = lane >> 5, l31 = lane & 31;
    const int b = bh >> 2, h = bh & 3; const int vt = wid & 3, ct = wid >> 2, kt0 = 2 * (wid >> 2);
    constexpr int ST = 0, UT = 34816, OT = 53248, WQ = 70656, QKD = 136192;
    float* Sg = p->p_amat + (size_t)bh * 16384;
    const bf16_t* gb = p->scanA + (size_t)bh * CPS * A_UNIT;
    const char* gbc = (const char*)gb;
    dma_pieces(lds, WQ, gb, 0, 16, wid, 8, lane);
    for (int q = wid; q < 16; q += 8) dma_one(lds, WQ + 16384 + q * 1024, gbc + 40960 + q * 1024, lane);
    for (int q = wid; q < 24; q += 8) dma_one(lds, QKD + q * 1024, gbc + (q < 8 ? 32768 + q * 1024 : 57344 + (q - 8) * 1024), lane);
    const u32x4* ug = (const u32x4*)(gbc + 16384 + ((ct * 4 + vt) * 64 + lane) * 32);
    u32x4 uc0 = ug[0], uc1 = ug[1];
    f32x16 S0 = zero16(), S1 = zero16();
    if (sst > 0) {
#pragma unroll
        for (int ii = 0; ii < 16; ++ii) { S0[ii] = Sg[(kt0 * 32 + crow(ii, hh)) * 128 + vt * 32 + l31]; S1[ii] = Sg[((kt0 + 1) * 32 + crow(ii, hh)) * 128 + vt * 32 + l31]; }
    }
    store_tile_T(lds, ST, 136, kt0 * 32, vt * 32, S0, lane); store_tile_T(lds, ST, 136, kt0 * 32 + 32, vt * 32, S1, lane);
    const int cg = tid & 15, rowA = tid >> 4;
    float anw[8];
#pragma unroll
    for (int k = 0; k < 8; ++k) anw[k] = p->a_norm_w[cg * 8 + k];
    WAIT_VM0();
    __syncthreads();
    for (int nl = 0; nl < CPS; ++nl) {
        const int chunk = sst * CPS + nl, ua = bh * CPS + nl; const bool more = nl + 1 < CPS;
        const char* gn = gbc + (size_t)(nl + 1) * (A_UNIT * 2);
        const int wq = WQ + (nl & 1) * 32768, wqn = WQ + ((nl + 1) & 1) * 32768;
        if (tid == 0) __hip_atomic_store(p->bar + XCD_BAR_WORDS + 64 * bh, (unsigned)(chunk + 1), __ATOMIC_RELAXED, __HIP_MEMORY_SCOPE_AGENT);
        const float gl = p->glast[ua];
        const size_t tok0 = (size_t)b * SEQ + chunk * 64 + rowA;
        const u32x4 gate0 = *(const u32x4*)(p->proj + tok0 * NPAD + 1536 + h * 128 + cg * 8), gate1 = *(const u32x4*)(p->proj + (tok0 + 32) * NPAD + 1536 + h * 128 + cg * 8);
        u32x4 un0 = uc0, un1 = uc1;
        if (more) { const u32x4* un = (const u32x4*)(gn + 16384 + ((ct * 4 + vt) * 64 + lane) * 32); un0 = un[0]; un1 = un[1]; }
        MEMBAR();
        if (more) {
            dma_one(lds, wqn + wid * 1024, gn + wid * 1024, lane); dma_one(lds, wqn + (wid + 8) * 1024, gn + (wid + 8) * 1024, lane);
            dma_one(lds, wqn + 16384 + wid * 1024, gn + 40960 + wid * 1024, lane); dma_one(lds, wqn + 16384 + (wid + 8) * 1024, gn + 40960 + (wid + 8) * 1024, lane); }
        MEMBAR();
        f32x16 au = zero16(), ao = zero16();
#pragma unroll
        for (int s = 0; s < 8; ++s) { const bf16x8 bS = LV8(ST + ((vt * 32 + l31) * 136 + s * 16 + 8 * hh) * 2);
            const bf16x8 aW = LV8(wq + ((ct * 8 + s) * 64 + lane) * 16), aQ = LV8(wq + 16384 + ((ct * 8 + s) * 64 + lane) * 16);
            au = MFMA32(aW, bS, au); ao = MFMA32(aQ, bS, ao); }
        { const f32x16 uc = expand16(uc0, uc1);
#pragma unroll
          for (int ii = 0; ii < 16; ++ii) au[ii] = uc[ii] - au[ii]; }
        store_tile_T(lds, UT, 72, ct * 32, vt * 32, au, lane);
        if (more) WAIT_VM4(); else WAIT_VM0();
        __syncthreads();
#pragma unroll
        for (int ii = 0; ii < 16; ++ii) { S0[ii] *= gl; S1[ii] *= gl; }
#pragma unroll
        for (int s = 0; s < 4; ++s) { const bf16x8 bU = LV8(UT + ((vt * 32 + l31) * 72 + s * 16 + 8 * hh) * 2);
            const bf16x8 aQK = LV8(QKD + ((ct * 4 + s) * 64 + lane) * 16);
            const bf16x8 aK0 = LV8(QKD + 8192 + ((kt0 * 4 + s) * 64 + lane) * 16), aK1 = LV8(QKD + 8192 + (((kt0 + 1) * 4 + s) * 64 + lane) * 16);
            ao = MFMA32(aQK, bU, ao); S0 = MFMA32(aK0, bU, S0); S1 = MFMA32(aK1, bU, S1); }
#pragma unroll
        for (int ii = 0; ii < 16; ++ii) LH(OT + ((ct * 32 + crow(ii, hh)) * 136 + vt * 32 + l31) * 2) = f2bf(ao[ii]);
        store_tile_T(lds, ST, 136, kt0 * 32, vt * 32, S0, lane); store_tile_T(lds, ST, 136, kt0 * 32 + 32, vt * 32, S1, lane);
        WAIT_VM0();
        __syncthreads();
        if (more) { for (int q = wid; q < 24; q += 8) dma_one(lds, QKD + q * 1024, gn + (q < 8 ? 32768 + q * 1024 : 57344 + (q - 8) * 1024), lane); }
#pragma unroll
        for (int k2 = 0; k2 < 2; ++k2) { const int row = rowA + 32 * k2; float ov[8];
            { const bf16x8 o8 = LV8(OT + (row * 136 + cg * 8) * 2);
#pragma unroll
              for (int k = 0; k < 8; ++k) ov[k] = bf2f((unsigned short)o8[k]); }
            float ss = 0.f;
#pragma unroll
            for (int k = 0; k < 8; ++k) ss += ov[k] * ov[k];
            ss = row_sum16(ss);
            const float rs = rsqrtf(ss * (1.f / 128.f) + 1e-6f); const u32x4 gt = k2 ? gate1 : gate0;
            const unsigned gw[4] = {gt.x, gt.y, gt.z, gt.w}; float rv[8];
#pragma unroll
            for (int k = 0; k < 8; ++k) { const float g = (k & 1) ? bfhi(gw[k >> 1]) : bflo(gw[k >> 1]); rv[k] = ov[k] * rs * anw[k] * siluf_(g); }
            u32x4 w; w.x = pack2(rv[0], rv[1]); w.y = pack2(rv[2], rv[3]); w.z = pack2(rv[4], rv[5]); w.w = pack2(rv[6], rv[7]);
            *(u32x4*)(p->xb + (tok0 + 32 * k2) * DM + h * 128 + cg * 8) = w; }
        uc0 = un0; uc1 = un1;
    }
    if (tid == 0) __hip_atomic_store(p->bar + XCD_BAR_WORDS + 64 * bh, (unsigned)((sst + 1) * CPS + 1), __ATOMIC_RELAXED, __HIP_MEMORY_SCOPE_AGENT);
    if (!dry)
#pragma unroll
    for (int ii = 0; ii < 16; ++ii) { Sg[(kt0 * 32 + crow(ii, hh)) * 128 + vt * 32 + l31] = S0[ii]; Sg[((kt0 + 1) * 32 + crow(ii, hh)) * 128 + vt * 32 + l31] = S1[ii]; }
    __syncthreads();
}

DI void scanB(int tidx, PARG p, LAS unsigned char* lds, int bhp, int sst, bool dry = false) {
    int tid_ = tidx; asm volatile("" : "+v"(tid_)); const int tid = tid_, lane = tid & 63, wid = __builtin_amdgcn_readfirstlane(tid >> 6), hh = lane >> 5, l31 = lane & 31;
    const int b = bhp >> 2, hsel = wid >> 2, h = (bhp & 3) * 2 + hsel, q = wid & 3, tt = q >> 1, vt = q & 1, kt = q >> 1;
    const int SS = hsel * 76800, CT = SS + 9216, YT = SS + 18432, RW = SS + 27648, BN = SS + 60416;
    float* Sg = p->p_bmat + (size_t)(b * 8 + h) * 4096;
    const bf16_t* gb = p->scanB + (size_t)(b * 8 + h) * CPS * B_UNIT;
    const char* gbc = (const char*)gb;
    for (int k = q; k < 16; k += 4) dma_one(lds, RW + k * 1024, gbc + (k < 8 ? k * 1024 : 24576 + (k - 8) * 1024), lane);
    for (int k = q; k < 16; k += 4) dma_one(lds, BN + k * 1024, gbc + 8192 + k * 1024, lane);
    f32x16 S = zero16();
    if (sst > 0) {
#pragma unroll
        for (int ii = 0; ii < 16; ++ii) S[ii] = Sg[(vt * 32 + l31) * 64 + kt * 32 + crow(ii, hh)];
    }
    store_tile_T(lds, SS, 72, kt * 32, vt * 32, S, lane);
    const int t256 = tid & 255, cg = t256 & 7, rowA = t256 >> 3, cB0 = h * 64 + cg * 8;
    float lnw[8], lnb[8], muv[8], mug[8];
#pragma unroll
    for (int k = 0; k < 8; ++k) { lnw[k] = p->ln_w[cB0 + k]; lnb[k] = p->ln_b[cB0 + k]; muv[k] = p->mu[1024 + cB0 + k]; mug[k] = p->mu[1536 + cB0 + k]; }
    const u32x4* ct0 = (const u32x4*)(gbc + 32768 + ((tt * 2 + vt) * 64 + lane) * 32);
    u32x4 cu0 = ct0[0], cu1 = ct0[1], cy0 = ct0[512], cy1 = ct0[513], ck0 = ct0[1024], ck1 = ct0[1025];
    WAIT_VM0();
    __syncthreads();
    for (int nl = 0; nl < CPS; ++nl) {
        const int chunk = sst * CPS + nl, ub = (b * 8 + h) * CPS + nl; const bool more = nl + 1 < CPS;
        const char* gn = gbc + (size_t)(nl + 1) * (B_UNIT * 2);
        const int rw = RW + (nl & 1) * 16384, rwn = RW + ((nl + 1) & 1) * 16384;
        if (tid == 0) __hip_atomic_store(p->bar + XCD_BAR_WORDS + 64 * (32 + bhp), (unsigned)(chunk + 1), __ATOMIC_RELAXED, __HIP_MEMORY_SCOPE_AGENT);
        const float* PTg = p->ptb + (size_t)ub * 64;
        float pt[16];
#pragma unroll
        for (int ii = 0; ii < 16; ++ii) pt[ii] = PTg[kt * 32 + crow(ii, hh)];
        const int tg0 = chunk * 64 + rowA; const size_t row0 = (size_t)b * SEQ + tg0; const bf16_t* pc0 = p->proj + row0 * NPAD + BOFF + cB0; const bf16_t* pc1 = pc0 + (size_t)32 * NPAD;
        const u32x4 z4 = {0u, 0u, 0u, 0u};
        const u32x4 vc0 = *(const u32x4*)(pc0 + 1024), gc0 = *(const u32x4*)(pc0 + 1536), vc1 = *(const u32x4*)(pc1 + 1024), gc1 = *(const u32x4*)(pc1 + 1536);
        const u32x4 vp0 = tg0 > 0 ? *(const u32x4*)(pc0 + 1024 - NPAD) : z4, gp0 = tg0 > 0 ? *(const u32x4*)(pc0 + 1536 - NPAD) : z4;
        const u32x4 vp1 = *(const u32x4*)(pc1 + 1024 - NPAD), gp1 = *(const u32x4*)(pc1 + 1536 - NPAD);
        const float bon0 = p->bonus[row0 * 8 + h], bon1 = p->bonus[(row0 + 32) * 8 + h];
        u32x4 nu0 = cu0, nu1 = cu1, ny0 = cy0, ny1 = cy1, nk0 = ck0, nk1 = ck1;
        if (more) { const u32x4* ctn = (const u32x4*)(gn + 32768 + ((tt * 2 + vt) * 64 + lane) * 32);
            nu0 = ctn[0]; nu1 = ctn[1]; ny0 = ctn[512]; ny1 = ctn[513]; nk0 = ctn[1024]; nk1 = ctn[1025]; }
        MEMBAR();
        if (more) {
            dma_one(lds, rwn + q * 1024, gn + q * 1024, lane); dma_one(lds, rwn + (q + 4) * 1024, gn + (q + 4) * 1024, lane);
            dma_one(lds, rwn + 8192 + q * 1024, gn + 24576 + q * 1024, lane); dma_one(lds, rwn + 8192 + (q + 4) * 1024, gn + 24576 + (q + 4) * 1024, lane); }
        MEMBAR();
        f32x16 aC = expand16(cu0, cu1), aY = expand16(cy0, cy1);
#pragma unroll
        for (int s = 0; s < 4; ++s) { const bf16x8 bS = LV8(SS + ((vt * 32 + l31) * 72 + s * 16 + 8 * hh) * 2);
            const bf16x8 aW = LV8(rw + 8192 + ((tt * 4 + s) * 64 + lane) * 16), aR = LV8(rw + ((tt * 4 + s) * 64 + lane) * 16);
            aC = MFMA32(aW, bS, aC); aY = MFMA32(aR, bS, aY); }
        store_tile_T(lds, CT, 72, tt * 32, vt * 32, aC, lane);
        { const f32x16 kv = expand16(ck0, ck1);
#pragma unroll
          for (int ii = 0; ii < 16; ++ii) S[ii] = pt[ii] * S[ii] + kv[ii]; }
        if (more) WAIT_VM4(); else WAIT_VM0();
        __syncthreads();
#pragma unroll
        for (int s = 0; s < 4; ++s) { const bf16x8 bC = LV8(CT + ((vt * 32 + l31) * 72 + s * 16 + 8 * hh) * 2);
            const bf16x8 aN = LV8(BN + 8192 + ((tt * 4 + s) * 64 + lane) * 16), aB = LV8(BN + ((kt * 4 + s) * 64 + lane) * 16);
            aY = MFMA32(aN, bC, aY); S = MFMA32(aB, bC, S); }
#pragma unroll
        for (int ii = 0; ii < 16; ++ii) LH(YT + ((tt * 32 + crow(ii, hh)) * 72 + vt * 32 + l31) * 2) = f2bf(aY[ii]);
        store_tile_T(lds, SS, 72, kt * 32, vt * 32, S, lane);
        WAIT_VM0();
        __syncthreads();
        if (more) { for (int k = q; k < 16; k += 4) dma_one(lds, BN + k * 1024, gn + 8192 + k * 1024, lane); }
#pragma unroll
        for (int k2 = 0; k2 < 2; ++k2) { const int row = rowA + 32 * k2; float yv[8];
            { const bf16x8 y8 = LV8(YT + (row * 72 + cg * 8) * 2);
#pragma unroll
              for (int k = 0; k < 8; ++k) yv[k] = bf2f((unsigned short)y8[k]); }
            float s1 = 0.f, s2 = 0.f;
#pragma unroll
            for (int k = 0; k < 8; ++k) { s1 += yv[k]; s2 += yv[k] * yv[k]; }
            s1 = row_sum8(s1); s2 = row_sum8(s2);
            const float mean = s1 * (1.f / 64.f); const float var = fmaxf(s2 * (1.f / 64.f) - mean * mean, 0.f); const float rstd = rsqrtf(var + 64e-5f);
            const u32x4 vc = k2 ? vc1 : vc0, vp = k2 ? vp1 : vp0, gc = k2 ? gc1 : gc0, gp = k2 ? gp1 : gp0; const float bon = k2 ? bon1 : bon0;
            const unsigned vcw[4] = {vc.x, vc.y, vc.z, vc.w}, vpw[4] = {vp.x, vp.y, vp.z, vp.w}, gcw[4] = {gc.x, gc.y, gc.z, gc.w}, gpw[4] = {gp.x, gp.y, gp.z, gp.w};
            float ov[8];
#pragma unroll
            for (int k = 0; k < 8; ++k) { const float vcur = (k & 1) ? bfhi(vcw[k >> 1]) : bflo(vcw[k >> 1]), vprv = (k & 1) ? bfhi(vpw[k >> 1]) : bflo(vpw[k >> 1]);
                const float gcur = (k & 1) ? bfhi(gcw[k >> 1]) : bflo(gcw[k >> 1]), gprv = (k & 1) ? bfhi(gpw[k >> 1]) : bflo(gpw[k >> 1]);
                const float vv = vcur + (vprv - vcur) * muv[k], gt = gcur + (gprv - gcur) * mug[k];
                const float gn2 = (yv[k] - mean) * rstd * lnw[k] + lnb[k]; ov[k] = (gn2 + bon * vv) * siluf_(gt); }
            u32x4 w; w.x = pack2(ov[0], ov[1]); w.y = pack2(ov[2], ov[3]); w.z = pack2(ov[4], ov[5]); w.w = pack2(ov[6], ov[7]);
            *(u32x4*)(p->xb + (row0 + 32 * k2) * DM + 512 + cB0) = w; }
        cu0 = nu0; cu1 = nu1; cy0 = ny0; cy1 = ny1; ck0 = nk0; ck1 = nk1;
    }
    if (tid == 0) __hip_atomic_store(p->bar + XCD_BAR_WORDS + 64 * (32 + bhp), (unsigned)((sst + 1) * CPS + 1), __ATOMIC_RELAXED, __HIP_MEMORY_SCOPE_AGENT);
    if (!dry)
#pragma unroll
    for (int ii = 0; ii < 16; ++ii) Sg[(vt * 32 + l31) * 64 + kt * 32 + crow(ii, hh)] = S[ii];
    __syncthreads();
}


DI void scan_helper(int tidx, PARG p, int r, int sst) {
    int tid_ = tidx; asm volatile("" : "+v"(tid_)); const int tid = tid_;
    unsigned* prog = p->bar + XCD_BAR_WORDS + 64 * r;
    for (int nl = 0; nl < CPS; ++nl) {
        if (tid == 0) { const unsigned need = (unsigned)(sst * CPS + nl - 1); unsigned spins = 0;
            while ((int)__hip_atomic_load(prog, __ATOMIC_RELAXED, __HIP_MEMORY_SCOPE_AGENT) < (int)need && ++spins < (1u << 20)) __builtin_amdgcn_s_sleep(4); }
        __syncthreads();
        if (r < 32) { const char* g = (const char*)(p->scanA + ((size_t)r * CPS + nl) * A_UNIT) + tid * 16;
#pragma unroll
            for (int k = 0; k < 9; ++k) { const u32x4 v = *(const u32x4*)(g + k * 8192); asm volatile("" :: "v"(v.x)); }
        } else { const int rb = r - 32, b = rb >> 2, h0 = (rb & 3) * 2;
#pragma unroll
            for (int hs = 0; hs < 2; ++hs) { const char* g = (const char*)(p->scanB + ((size_t)(b * 8 + h0 + hs) * CPS + nl) * B_UNIT) + tid * 16;
#pragma unroll
                for (int k = 0; k < 7; ++k) { const u32x4 v = *(const u32x4*)(g + k * 8192); asm volatile("" :: "v"(v.x)); } }
        }
    }
}

DI void sample_token(int tidx, PARG p, LAS unsigned char* lds, int b) {
    int tid_ = tidx; asm volatile("" : "+v"(tid_)); const int tid = tid_, lane = tid & 63, wid = __builtin_amdgcn_readfirstlane(tid >> 6);
    constexpr int QKV = 0, XBS = 1536 * 4, TWS = 3712 * 4, WDEC = 3776 * 4, ASG = 4288 * 4, KKR = 4800 * 4, KMOD = 5312 * 4, KKS = 5824 * 4, NRM = 6336 * 4, BG = 6344 * 4, BON = 6352 * 4, PART = 6360 * 4;
    const size_t R = NTOK + b; const bf16_t* pr = p->proj + R * NPAD;
#pragma unroll
    for (int m = 0; m < 3; ++m) { const int c = tid + 512 * m; const float* sc = p->state_a_conv + (size_t)b * 3 * 1536 + c; const float s0 = sc[0], s1 = sc[1536], s2 = sc[3072], cur = bf2f(pr[c]);
        const float o = s0 * p->conv_w[c] + s1 * p->conv_w[1536 + c] + s2 * p->conv_w[3072 + c] + cur * p->conv_w[4608 + c];
        LF(QKV + c * 4) = siluf_(o); float* oc = p->s_aconv + (size_t)b * 3 * 1536 + c; oc[0] = s1; oc[1536] = s2; oc[3072] = cur; }
    for (int j = tid; j < BW; j += 512) { const float cur = bf2f(pr[BOFF + j]), prev = p->state_b_shift[(size_t)b * BW + j];
        LF(XBS + j * 4) = cur + (prev - cur) * p->mu[j]; p->s_bshift[(size_t)b * BW + j] = cur; }
    LBAR();
    { const int hd = wid & 3, which = wid >> 2; const int o0 = which * 512 + hd * 128 + lane * 2; const float a = LF(QKV + o0 * 4), c = LF(QKV + (o0 + 1) * 4);
      const float ss = wave_sum(a * a + c * c); if (lane == 0) LF(NRM + wid * 4) = rsqrtf(ss + 1e-12f) * (which == 0 ? 0.08838834764831845f : 1.f); }
    if (tid < 4) { LF(BG + tid * 4) = sigmoidf_(bf2f(pr[2048 + tid])); LF(BG + (4 + tid) * 4) = __expf(-__expf(p->a_log[tid]) * softplusf_(bf2f(pr[2052 + tid]) + p->dt_bias[tid])); }
    if (tid < 64) LF(TWS + tid * 4) = tanhf_(LF(XBS + (2048 + tid) * 4));
    LBAR();
    { const int cB = tid; float lw = 0.f, la = 0.f;
#pragma unroll 4
      for (int l0 = 0; l0 < 64; l0 += 16) { float wv[16], av[16];
#pragma unroll
          for (int l = 0; l < 16; ++l) { wv[l] = p->w2[(l0 + l) * 512 + cB]; av[l] = p->a2[(l0 + l) * 512 + cB]; }
#pragma unroll
          for (int l = 0; l < 16; ++l) { lw += LF(TWS + (l0 + l) * 4) * wv[l]; la += LF(XBS + (2112 + l0 + l) * 4) * av[l]; } }
      const float a = sigmoidf_(p->a0[cB] + la); const float kr = LF(XBS + (512 + cB) * 4);
      LF(WDEC + cB * 4) = __expf(-0.6065306597126334f * sigmoidf_(p->w0[cB] + lw)); LF(ASG + cB * 4) = a; LF(KKR + cB * 4) = kr * p->k_k[cB]; LF(KMOD + cB * 4) = kr * (1.f + (a - 1.f) * p->k_a[cB]); }
    LBAR();
    { const int cB = wid * 64 + lane; const float kv = LF(KKR + cB * 4); const float ss = wave_sum(kv * kv); LF(KKS + cB * 4) = kv * rsqrtf(ss + 1e-12f);
      const float bon = wave_sum(LF(XBS + cB * 4) * LF(KMOD + cB * 4) * p->r_k[cB]); if (lane == 0) LF(BON + wid * 4) = bon; }
    LBAR();
    {
        const int hd = tid >> 7, v = tid & 127; const float* S0 = p->state_a_mat + ((size_t)b * 4 + hd) * 16384 + v; float* S1 = p->s_amat + ((size_t)b * 4 + hd) * 16384 + v;
        const float nq = LF(NRM + hd * 4), nk = LF(NRM + (4 + hd) * 4), beta = LF(BG + hd * 4), eg = LF(BG + (4 + hd) * 4);
        float kS = 0.f, qS = 0.f, qk = 0.f;
#pragma unroll 1
        for (int k0 = 0; k0 < 128; k0 += 32) { float sv[32];
#pragma unroll
            for (int k = 0; k < 32; ++k) sv[k] = S0[(k0 + k) * 128];
#pragma unroll
            for (int k = 0; k < 32; ++k) { const float qn = LF(QKV + (hd * 128 + k0 + k) * 4) * nq, kn = LF(QKV + (512 + hd * 128 + k0 + k) * 4) * nk; kS += kn * sv[k]; qS += qn * sv[k]; qk += qn * kn; } }
        const float vval = LF(QKV + (1024 + hd * 128 + v) * 4); const float u = beta * (vval - eg * kS); const float o = eg * qS + qk * u;
#pragma unroll 1
        for (int k0 = 0; k0 < 128; k0 += 32) { float sv[32];
#pragma unroll
            for (int k = 0; k < 32; ++k) sv[k] = S0[(k0 + k) * 128];
#pragma unroll
            for (int k = 0; k < 32; ++k) { const float kn = LF(QKV + (512 + hd * 128 + k0 + k) * 4) * nk; S1[(k0 + k) * 128] = eg * sv[k] + kn * u; } }
        const float ss = wave_sum(o * o); if (lane == 0) LF(PART + wid * 4) = ss;
        LBAR();
        const float rs = rsqrtf((LF(PART + (2 * hd) * 4) + LF(PART + (2 * hd + 1) * 4)) * (1.f / 128.f) + 1e-6f);
        const float gate = bf2f(pr[1536 + hd * 128 + v]);
        p->xb[R * DM + hd * 128 + v] = f2bf(o * rs * p->a_norm_w[v] * siluf_(gate));
    }
    {
        const int hd = wid, v = lane, cB = hd * 64 + v; const float* S0 = p->state_b_mat + (((size_t)b * 8 + hd) * 64 + v) * 64; float* S1 = p->s_bmat + (((size_t)b * 8 + hd) * 64 + v) * 64;
        f32x4 s[16]; float sa = 0.f;
#pragma unroll
        for (int i = 0; i < 16; ++i) { s[i] = *(const f32x4*)(S0 + 4 * i);
#pragma unroll
            for (int j = 0; j < 4; ++j) sa -= s[i][j] * LF(KKS + (hd * 64 + 4 * i + j) * 4); }
        const float vv = LF(XBS + (1024 + cB) * 4); float y = 0.f;
#pragma unroll
        for (int i = 0; i < 16; ++i) {
#pragma unroll
            for (int j = 0; j < 4; ++j) { const int k = hd * 64 + 4 * i + j; const float sn = s[i][j] * LF(WDEC + k * 4) + sa * (LF(KKS + k * 4) * LF(ASG + k * 4)) + vv * LF(KMOD + k * 4); s[i][j] = sn; y += sn * LF(XBS + k * 4); }
            *(f32x4*)(S1 + 4 * i) = s[i]; }
        const float mean = wave_sum(y) * (1.f / 64.f); const float d = y - mean; const float var = wave_sum(d * d) * (1.f / 64.f);
        const float gn = d * rsqrtf(var + 64e-5f) * p->ln_w[cB] + p->ln_b[cB];
        p->xb[R * DM + 512 + cB] = f2bf((gn + LF(BON + hd * 4) * vv) * siluf_(LF(XBS + (1536 + cB) * 4)));
    }
    LBAR();
}

DI void prompt_tail_states(int tidx, PARG p, int b) {
    int tid_ = tidx; asm volatile("" : "+v"(tid_));
    for (int e = tid_; e < 3 * 1536; e += 512) { const int i = e / 1536, c = e % 1536; p->p_aconv[(size_t)b * 4608 + e] = bf2f(p->proj[(size_t)(b * SEQ + 2045 + i) * NPAD + c]); }
    for (int j = tid_; j < BW; j += 512) p->p_bshift[(size_t)b * BW + j] = bf2f(p->proj[(size_t)(b * SEQ + 2047) * NPAD + BOFF + j]);
}

DI void final_norm(int tidx, PARG p) {
    int tid_ = tidx; asm volatile("" : "+v"(tid_)); const int lane = tid_ & 63, wid = __builtin_amdgcn_readfirstlane(tid_ >> 6);
    const int stride = gridDim.x * 8; f32x4 fw[4];
#pragma unroll
    for (int i = 0; i < 4; ++i) fw[i] = *(const f32x4*)(p->final_norm_w + i * 256 + lane * 4);
    for (int row0 = blockIdx.x * 8 + wid; row0 < MROWS; row0 += 4 * stride) {
        f32x4 v[4][4]; float ssr[4];
#pragma unroll
        for (int r = 0; r < 4; ++r) { const int row = row0 + r * stride; ssr[r] = 0.f;
            if (row < MROWS) { ssr[r] = lane < 16 ? p->rowss[(size_t)row * 16 + lane] : 0.f; const float* yr = p->y + (size_t)row * DM;
#pragma unroll
                for (int i = 0; i < 4; ++i) v[r][i] = *(const f32x4*)(yr + i * 256 + lane * 4); } }
#pragma unroll
        for (int r = 0; r < 4; ++r) { const int row = row0 + r * stride;
            if (row < MROWS) { const float sc = rsqrtf(wave_sum(ssr[r]) * (1.f / 1024.f) + 1e-6f); float* yr = p->y + (size_t)row * DM;
#pragma unroll
                for (int i = 0; i < 4; ++i) { f32x4 o; o[0] = v[r][i][0] * sc * fw[i][0]; o[1] = v[r][i][1] * sc * fw[i][1]; o[2] = v[r][i][2] * sc * fw[i][2]; o[3] = v[r][i][3] * sc * fw[i][3];
                    *(f32x4*)(yr + i * 256 + lane * 4) = o; } } }
    }
}

#ifdef DBL_SYNC
#define GSYNC1() do { XcdBarrier xb2; xb2.bar = OPAQUE(kp)->bar; xb2.x = xb_xcc_id(); xb2.st = xst; xcd_barrier(xb2, wave_idx == 0 && LANEID == 0); } while (0)
#define GSYNC() do { GSYNC1(); GSYNC1(); } while (0)
#else
#define GSYNC() do { XcdBarrier xb2; xb2.bar = OPAQUE(kp)->bar; xb2.x = xb_xcc_id(); xb2.st = xst; xcd_barrier(xb2, wave_idx == 0 && LANEID == 0); } while (0)
#endif
__global__ void __launch_bounds__(512, 2) hymba_step_megakernel(Params pv) {
    extern __shared__ __attribute__((aligned(16))) unsigned char shm[];
    LAS unsigned char* lds = (LAS unsigned char*)shm;
    cg::grid_group grid = cg::this_grid();
    volatile LAS unsigned* xst = (volatile LAS unsigned*)(lds + LDS_BYTES - 16);
    if (threadIdx.x == 0) { xst[0] = 0u; xst[1] = 0u; xst[2] = 0u; xst[3] = 0u; }
    __syncthreads();
    const int G = gridDim.x, wg = blockIdx.x;
    const int wave_idx = __builtin_amdgcn_readfirstlane(threadIdx.x >> 6);
#define LANEID ({ int l_; asm volatile("v_mbcnt_lo_u32_b32 %0, -1, 0\n\tv_mbcnt_hi_u32_b32 %0, -1, %0" : "=v"(l_)); l_; })
#define TIDX (wave_idx * 64 + LANEID)
    PARG kp = (PARG)__builtin_amdgcn_kernarg_segment_ptr();
    if (__builtin_expect(pv.y == nullptr, 1)) { grid.sync(); return; }
    (void)xcd_barrier_post(pv.bar, xst);

    phase0(TIDX, OPAQUE(kp), lds);
#ifdef DBL_G
    __syncthreads(); phase0(TIDX, OPAQUE(kp), lds);
#endif
    GSYNC();
#ifdef DBL_G
    { PARG p = OPAQUE(kp); pg8::Gemm g; g.A = p->xb; g.Bt = p->winT; g.M = MPAD; g.N = NPAD; g.K = DM;
      pg8::StaticOrder S; S.init(MPAD, NPAD, G, wg); EpiProj E; E.O = p->proj; E.ldc = NPAD;
      pg8::gemm_phase<EpiProj, pg8::StaticOrder, false>(lds, g, S, E, nullptr, TIDX); }
    __syncthreads();
#endif
    { PARG p = OPAQUE(kp); pg8::Gemm g; g.A = p->xb; g.Bt = p->winT; g.M = MPAD; g.N = NPAD; g.K = DM;
      pg8::StaticOrder S; S.init(MPAD, NPAD, G, wg); EpiProj E; E.O = p->proj; E.ldc = NPAD;
      pg8::gemm_phase<EpiProj, pg8::StaticOrder, false>(lds, g, S, E, nullptr, TIDX); }
    GSYNC();
#define P2_QUEUE(t) do { \
        _Pragma("unroll 1") for (;;) { \
            LBAR(); \
            if (TIDX == 0) *(volatile LAS unsigned*)(lds + LDS_BYTES - 32) = __hip_atomic_fetch_add(OPAQUE(kp)->bar + XCD_BAR_WORDS + 4096 + 64 * (t), 1u, __ATOMIC_RELAXED, __HIP_MEMORY_SCOPE_AGENT); \
            LBAR(); \
            const int q_ = (int)*(volatile LAS unsigned*)(lds + LDS_BYTES - 32); \
            if (q_ >= 96 * CPS) break; \
            const int nl_ = q_ / 96, r_ = q_ % 96; const bool isA_ = r_ < 32; const int bhB_ = r_ - 32; \
            const int srole_ = isA_ ? r_ : 32 + (bhB_ >> 3) * 4 + ((bhB_ & 7) >> 1); \
            if ((t) > 0) { if (TIDX == 0) { const int need_ = ((t) - 1) * CPS + nl_ + 2; unsigned sp_ = 0; \
                    while ((int)__hip_atomic_load(OPAQUE(kp)->bar + XCD_BAR_WORDS + 64 * srole_, __ATOMIC_RELAXED, __HIP_MEMORY_SCOPE_AGENT) < need_ && ++sp_ < (1u << 22)) __builtin_amdgcn_s_sleep(4); } \
                __syncthreads(); } \
            if (isA_) p2a_unit(TIDX, OPAQUE(kp), lds, r_ >> 2, r_ & 3, (t) * CPS + nl_, r_ * CPS + nl_); \
            else p2b_unit(TIDX, OPAQUE(kp), lds, bhB_ >> 3, bhB_ & 7, (t) * CPS + nl_, bhB_ * CPS + nl_); \
        } } while (0)
    P2_QUEUE(0);
    GSYNC();
#pragma unroll 1
    for (int sst = 0; sst < NSUPER; ++sst) {
        const bool helpers = false;
        const int nscan = 64, nsmp = sst == 0 ? 48 : (sst < 3 ? 40 : 0), tokb = sst == 0 ? 0 : (sst == 1 ? 48 : 88); const int nhelp = helpers ? 64 : 0; const int nroles = nscan + nsmp + nhelp + (sst == 3 ? 4 : 0);
#pragma unroll 1
        for (int role = wg; role < nroles; role += G) {
            if (role < 32) scanA(TIDX, OPAQUE(kp), lds, role, sst);
            else if (role < 64) scanB(TIDX, OPAQUE(kp), lds, role - 32, sst);
            else if (role < nscan + nsmp) { const int sb = tokb + role - 64; sample_token(TIDX, OPAQUE(kp), lds, sb); if (sb < 8) prompt_tail_states(TIDX, OPAQUE(kp), sb); }
            else if (role < nscan + nsmp + nhelp) scan_helper(TIDX, OPAQUE(kp), role - nscan - nsmp, sst);
            else {
                PARG p = OPAQUE(kp); pg8::Gemm g; g.A = p->xb; g.Bt = p->woutT; g.M = MPAD; g.N = DM; g.K = DM;
                OneUnit S1; S1.pm = 64; S1.pn = role - (nscan + nsmp + nhelp); EpiOut E; E.xp = p->x_prompt; E.xs = p->x_sample; E.out = p->y; E.rowss = p->rowss;
                pg8::gemm_phase<EpiOut, OneUnit, false>(lds, g, S1, E, nullptr, TIDX); }
        }
        if (sst + 1 < NSUPER) P2_QUEUE(sst + 1);
        GSYNC();
    }
#ifdef DBL_G
    { PARG p = OPAQUE(kp); pg8::Gemm g; g.A = p->xb; g.Bt = p->woutT; g.M = MPAD; g.N = DM; g.K = DM;
      pg8::StaticOrder S; S.init(NTOK, DM, G, wg); EpiOut E; E.xp = p->x_prompt; E.xs = p->x_sample; E.out = p->y; E.rowss = p->rowss;
      pg8::gemm_phase<EpiOut, pg8::StaticOrder, false>(lds, g, S, E, nullptr, TIDX); }
    __syncthreads();
#endif
    { PARG p = OPAQUE(kp); pg8::Gemm g; g.A = p->xb; g.Bt = p->woutT; g.M = MPAD; g.N = DM; g.K = DM;
      pg8::StaticOrder S; S.init(NTOK, DM, G, wg); EpiOut E; E.xp = p->x_prompt; E.xs = p->x_sample; E.out = p->y; E.rowss = p->rowss;
      pg8::gemm_phase<EpiOut, pg8::StaticOrder, false>(lds, g, S, E, nullptr, TIDX); }
    GSYNC();
    final_norm(TIDX, OPAQUE(kp));
}

extern "C" void kernel_launch(void* const* d_in, const int* in_sizes, int n_in, void* d_out, int out_size, void* d_ws, size_t ws_size, hipStream_t stream) {
    (void)in_sizes; (void)n_in; (void)out_size; (void)ws_size;
    static int grid_blocks = 0;
    if (!grid_blocks) {
        int dev = 0, cus = 0, per_cu = 0;
        hipGetDevice(&dev);
        hipDeviceGetAttribute(&cus, hipDeviceAttributeMultiprocessorCount, dev);
        if (hipFuncSetAttribute((const void*)hymba_step_megakernel, hipFuncAttributeMaxDynamicSharedMemorySize, LDS_BYTES) != hipSuccess) fprintf(stderr, "hipFuncSetAttribute failed\n");
        if (hipOccupancyMaxActiveBlocksPerMultiprocessor(&per_cu, (const void*)hymba_step_megakernel, 512, LDS_BYTES) != hipSuccess || per_cu < 1) per_cu = 1;
        grid_blocks = cus * per_cu; if (grid_blocks > 256) grid_blocks = 256;
    }
    Params p{};
    const float* const* in = (const float* const*)d_in;
    p.x_prompt = in[0]; p.x_sample = in[1]; p.state_a_mat = in[2]; p.state_a_conv = in[3]; p.state_b_mat = in[4]; p.state_b_shift = in[5];
    p.norm_w = in[6]; p.w_in = in[7]; p.conv_w = in[8]; p.a_log = in[9]; p.dt_bias = in[10]; p.a_norm_w = in[11]; p.mu = in[12]; p.w0 = in[13]; p.w2 = in[14];
    p.a0 = in[15]; p.a2 = in[16]; p.k_k = in[17]; p.k_a = in[18]; p.r_k = in[19]; p.ln_w = in[20]; p.ln_b = in[21]; p.w_out = in[22]; p.final_norm_w = in[23];
    float* o = (float*)d_out;
    p.y = o; o += (size_t)MROWS * DM;
    p.p_amat = o; o += 8 * 4 * 128 * 128; p.p_aconv = o; o += 8 * 3 * 1536; p.p_bmat = o; o += 8 * 8 * 64 * 64; p.p_bshift = o; o += 8 * BW;
    p.s_amat = o; o += (size_t)128 * 4 * 128 * 128; p.s_aconv = o; o += 128 * 3 * 1536; p.s_bmat = o; o += (size_t)128 * 8 * 64 * 64; p.s_bshift = o;
    unsigned char* w = (unsigned char*)d_ws; size_t off = 0;
    auto take = [&](size_t bytes) { unsigned char* r = w + off; off += (bytes + 255) & ~(size_t)255; return r; };
    p.xb = (bf16_t*)take((size_t)MPAD * DM * 2); p.winT = (bf16_t*)take((size_t)NPAD * DM * 2); p.woutT = (bf16_t*)take((size_t)DM * DM * 2);
    p.proj = (bf16_t*)take((size_t)MPAD * NPAD * 2);
    p.scanA = (bf16_t*)take((size_t)32 * CPS * A_UNIT * 2); p.scanB = (bf16_t*)take((size_t)64 * CPS * B_UNIT * 2);
    p.glast = (float*)take(32 * CPS * 4); p.ptb = (float*)take((size_t)64 * CPS * 64 * 4); p.bonus = (float*)take((size_t)NTOK * 8 * 4); p.rowss = (float*)take((size_t)MPAD * 16 * 4);
    p.bar = (unsigned*)take((XCD_BAR_WORDS + 4096 + 8 * 64) * 4);
    hipMemsetAsync(p.bar, 0, (XCD_BAR_WORDS + 4096 + 8 * 64) * 4, stream);
    void* args[] = {&p};
    hipError_t e = hipLaunchCooperativeKernel((const void*)hymba_step_megakernel, dim3(grid_blocks), dim3(512), args, LDS_BYTES, stream);
    if (e != hipSuccess) fprintf(stderr, "cooperative launch failed: %s (grid %d)\n", hipGetErrorString(e), grid_blocks);
}
```

```cpp
#include <hip/hip_runtime.h>
#include <hip/hip_cooperative_groups.h>
#include <cstdio>
namespace cg = cooperative_groups;
namespace pg8 {
#define PG8_LAS __attribute__((address_space(3)))
typedef unsigned short bf16_t;
typedef short bf16x8 __attribute__((ext_vector_type(8)));
typedef float f32x4 __attribute__((ext_vector_type(4)));
typedef unsigned u32x4 __attribute__((ext_vector_type(4)));
constexpr int BM = 256, BK = 64, HALF = 128, HTB = HALF * BK * 2  , STAGE_BYTES = 8 * HTB, NXCD = 8, WGM = 8;

__host__ __device__ __forceinline__ int lds_byte(int r, int c) { const int st = (r >> 4) * 2 + (c >> 5), rr = r & 15, cc = c & 31, ob = rr * 64 + cc * 2; return st * 1024 + (ob ^ (((ob >> 9) & 1) << 5)); }
__host__ __device__ __forceinline__ void stage_rc(int b, int& R, int& C) { const int st = b / 1024, sb = b % 1024, swz = sb ^ (((sb >> 9) & 1) << 5); R = (st >> 1) * 16 + swz / 64; C = (st & 1) * 32 + (swz % 64) / 2; }
__host__ __device__ __forceinline__ int perm32(int rho) { const int n = rho >> 4, i = rho & 15; return 8 * (i >> 2) + 4 * n + (i & 3); }

struct Unit { int pm, pn; };
struct Gemm { const bf16_t* A; const bf16_t* Bt; int M, N, K; };

struct StaticOrder {
    int nM, nN, nwg, G, c;
    __host__ __device__ void init(int M, int N, int G_, int c_) { nM = M / BM; nN = N / BM; nwg = nM * nN; G = G_; c = c_; }
    __host__ __device__ bool next(int i, Unit& u) const {
        const long L = (long)i * G + c; if (L >= nwg) return false;
        int wgid = (int)L; { const int q = nwg / NXCD, r = nwg % NXCD, xcd = wgid % NXCD, off = wgid / NXCD; wgid = (xcd < r ? xcd * (q + 1) : r * (q + 1) + (xcd - r) * q) + off; }
        const int nig = WGM * nN, gid = wgid / nig, fm = gid * WGM, gsz = (nM - fm) < WGM ? (nM - fm) : WGM;
        u.pm = fm + ((wgid % nig) % gsz); u.pn = (wgid % nig) / gsz; return true;
    }
    __device__ __forceinline__ void a_ready(const Unit&) const {}
    __device__ __forceinline__ void done(const Unit&) const {}
};

template <class Epi, class Sched, bool STAMP = false>
__device__ __forceinline__ void gemm_phase(PG8_LAS unsigned char* lds, const Gemm g, const Sched& S, const Epi& E, unsigned long long* stamps, int tidx) {
    int tid_ = tidx; asm volatile("" : "+v"(tid_));
    const int tid = tid_, wid = __builtin_amdgcn_readfirstlane(tid >> 6), lane = tid & 63, wr = wid >> 2, wc = wid & 3, fr = lane & 15, fq = lane >> 4;
    const int K = g.K, nt = K / BK;
    int ts_lo = 0, ts_hi = 0, nts = 0; const unsigned long long rt_entry = STAMP ? (unsigned long long)wall_clock64() : 0ull;
#define PG8_STAMP() do { if (STAMP && wid == 0 && nts < 64) { const unsigned long long _c = (unsigned long long)clock64(); \
        ts_lo = (lane == nts) ? (int)(unsigned)_c : ts_lo; ts_hi = (lane == nts) ? (int)(unsigned)(_c >> 32) : ts_hi; ++nts; } } while (0)
    PG8_STAMP();
    unsigned voffA[2], voffB[2];
#pragma unroll
    for (int i = 0; i < 2; ++i) { int R, C; stage_rc(tid * 16 + i * 8192, R, C); const int Rb = Epi::PERM ? ((R & ~31) + perm32(R & 31)) : R;
        voffA[i] = (unsigned)(R * K + C) * 2u; voffB[i] = (unsigned)(Rb * K + C) * 2u; }
    const size_t kstep = (size_t)(BK * 2);
    const size_t hstep = (size_t)HALF * K * 2;
    const size_t tstep = 2 * hstep;
    const unsigned ldsw = (unsigned)wid * 1024u;
    const int aoff = lds_byte(wr * 64 + fr, fq * 8), boff = lds_byte(wc * 32 + fr, fq * 8);
#define PG8_SA(b, h) (((b) * 2 + (h)) * HTB)
#define PG8_SB(b, h) ((4 + (b) * 2 + (h)) * HTB)
#define PG8_STAGE(bufoff, gbase, voff) do { _Pragma("unroll") for (int _i = 0; _i < 2; ++_i) \
        __builtin_amdgcn_global_load_lds((const unsigned*)((const char*)(gbase) + (voff)[_i]), (PG8_LAS unsigned*)(lds + (bufoff) + ldsw + _i * 8192), 16, 0, 0); } while (0)
#define PG8_LDA(dst, b, h) do { _Pragma("unroll") for (int m = 0; m < 4; ++m) _Pragma("unroll") for (int k = 0; k < 2; ++k) dst[m][k] = *(const PG8_LAS bf16x8*)(lds + PG8_SA(b, h) + aoff + m * 2048 + k * 1024); } while (0)
#define PG8_LDB(dst, b, h) do { _Pragma("unroll") for (int n = 0; n < 2; ++n) _Pragma("unroll") for (int k = 0; k < 2; ++k) dst[n][k] = *(const PG8_LAS bf16x8*)(lds + PG8_SB(b, h) + boff + n * 2048 + k * 1024); } while (0)
#define PG8_MMA(ai, bj, At, Bt) do { __builtin_amdgcn_s_setprio(1); _Pragma("unroll") for (int m = 0; m < 4; ++m) _Pragma("unroll") for (int n = 0; n < 2; ++n) _Pragma("unroll") for (int k = 0; k < 2; ++k) \
        acc[ai][bj][m][n] = __builtin_amdgcn_mfma_f32_16x16x32_bf16(Bt[n][k], At[m][k], acc[ai][bj][m][n], 0, 0, 0); __builtin_amdgcn_s_setprio(0); } while (0)
#define PG8_WAIT_V(n) asm volatile("s_waitcnt vmcnt(" #n ")" ::: "memory")
#define PG8_WAIT_L(n) asm volatile("s_waitcnt lgkmcnt(" #n ")" ::: "memory")
#define PG8_BAR __builtin_amdgcn_s_barrier()
#define PG8_SCHED __builtin_amdgcn_sched_barrier(0)
    Unit cur, nxt; int ui = 0;
    if (!S.next(0, cur)) return;
    f32x4 acc[2][2][4][2];
#pragma unroll
    for (int a = 0; a < 2; ++a)
#pragma unroll
        for (int b = 0; b < 2; ++b)
#pragma unroll
            for (int m = 0; m < 4; ++m)
#pragma unroll
                for (int n = 0; n < 2; ++n) acc[a][b][m][n] = (f32x4){0.f, 0.f, 0.f, 0.f};
    bf16x8 At[4][2], B0[2][2], B1[2][2];
    const char* cA = (const char*)g.A + (size_t)cur.pm * tstep; const char* cB = (const char*)g.Bt + (size_t)cur.pn * tstep;
    S.a_ready(cur);
    PG8_STAGE(PG8_SB(0, 0), cB, voffB); PG8_STAGE(PG8_SA(0, 0), cA, voffA); PG8_STAGE(PG8_SB(0, 1), cB + hstep, voffB); PG8_STAGE(PG8_SA(0, 1), cA + hstep, voffA);
    if (wr == 1) PG8_BAR;
    PG8_WAIT_V(4); PG8_BAR;
    PG8_STAGE(PG8_SB(1, 0), cB + kstep, voffB); PG8_STAGE(PG8_SA(1, 0), cA + kstep, voffA); PG8_STAGE(PG8_SB(1, 1), cB + hstep + kstep, voffB);
    PG8_WAIT_V(6); PG8_BAR;
    PG8_STAMP();
    for (;;) {
        const bool has_next = S.next(ui + 1, nxt);
        const char* nA = has_next ? (const char*)g.A + (size_t)nxt.pm * tstep : cA; const char* nB = has_next ? (const char*)g.Bt + (size_t)nxt.pn * tstep : cB;
        for (int t = 0; t < nt; t += 2) {
            const bool last = (t == nt - 2);
            const char* a1 = cA + (size_t)(t + 1) * kstep;
            const char* a2 = last ? nA : cA + (size_t)(t + 2) * kstep; const char* b2 = last ? nB : cB + (size_t)(t + 2) * kstep;
            const char* a3 = a2 + kstep; const char* b3 = b2 + kstep;
            if (last && has_next) S.a_ready(nxt);
            PG8_LDB(B0, 0, 0); PG8_SCHED; PG8_LDA(At, 0, 0); PG8_STAGE(PG8_SA(1, 1), a1 + hstep, voffA);
            PG8_WAIT_L(8); PG8_BAR; PG8_WAIT_L(0); PG8_MMA(0, 0, At, B0); PG8_BAR; PG8_SCHED;
            PG8_LDB(B1, 0, 1); PG8_STAGE(PG8_SB(0, 0), b2, voffB);
            PG8_BAR; PG8_WAIT_L(0); PG8_MMA(0, 1, At, B1); PG8_BAR;
            PG8_LDA(At, 0, 1); PG8_STAGE(PG8_SA(0, 0), a2, voffA);
            PG8_BAR; PG8_WAIT_L(0); PG8_MMA(1, 0, At, B0); PG8_BAR; PG8_SCHED;
            PG8_STAGE(PG8_SB(0, 1), b2 + hstep, voffB);
            PG8_WAIT_V(6); PG8_BAR; PG8_MMA(1, 1, At, B1); PG8_BAR;
            PG8_LDB(B0, 1, 0); PG8_SCHED; PG8_LDA(At, 1, 0); PG8_STAGE(PG8_SA(0, 1), a2 + hstep, voffA);
            PG8_WAIT_L(8); PG8_BAR; PG8_WAIT_L(0); PG8_MMA(0, 0, At, B0); PG8_BAR; PG8_SCHED;
            PG8_LDB(B1, 1, 1); PG8_STAGE(PG8_SB(1, 0), b3, voffB);
            PG8_BAR; PG8_WAIT_L(0); PG8_MMA(0, 1, At, B1); PG8_BAR;
            PG8_LDA(At, 1, 1); PG8_STAGE(PG8_SA(1, 0), a3, voffA);
            PG8_BAR; PG8_WAIT_L(0); PG8_MMA(1, 0, At, B0); PG8_BAR; PG8_SCHED;
            PG8_STAGE(PG8_SB(1, 1), b3 + hstep, voffB);
            PG8_WAIT_V(6); PG8_BAR; PG8_MMA(1, 1, At, B1); PG8_BAR;
        }
        PG8_STAMP();
        if constexpr (!Epi::AFTER_DRAIN) { E(acc, cur, wr, wc, fr, fq); S.done(cur); }
        PG8_STAMP();
        if (!has_next) break;
#pragma unroll
        for (int a = 0; a < 2; ++a)
#pragma unroll
            for (int b = 0; b < 2; ++b)
#pragma unroll
                for (int m = 0; m < 4; ++m)
#pragma unroll
                    for (int n = 0; n < 2; ++n) acc[a][b][m][n] = (f32x4){0.f, 0.f, 0.f, 0.f};
        cur = nxt; cA = nA; cB = nB; ++ui;
    }
    PG8_WAIT_V(0);
    if (wr == 0) PG8_BAR;
    PG8_BAR;
    if constexpr (Epi::AFTER_DRAIN) { E.fused(acc, cur, wr, wc, fr, fq, lds, wid, lane); S.done(cur); }
    PG8_STAMP();
    if (STAMP && wid == 0) { stamps[lane] = lane < nts ? (((unsigned long long)(unsigned)ts_hi << 32) | (unsigned)ts_lo) : 0ull;
        if (lane == 62) stamps[62] = rt_entry; if (lane == 63) stamps[63] = (unsigned long long)wall_clock64(); }
#undef PG8_STAMP
#undef PG8_SA
#undef PG8_SB
#undef PG8_STAGE
#undef PG8_LDA
#undef PG8_LDB
#undef PG8_MMA
#undef PG8_WAIT_V
#undef PG8_WAIT_L
#undef PG8_BAR
#undef PG8_SCHED
}
}

__device__ __forceinline__ unsigned cvt_pk_bf16(float lo, float hi) { unsigned r; asm volatile("v_cvt_pk_bf16_f32 %0, %1, %2" : "=v"(r) : "v"(lo), "v"(hi)); return r; }
#define LAS __attribute__((address_space(3)))

#define XB_TMO      128
#define XB_XCNT(j)  (256  + 64 * (j))
#define XB_XSUB(j)  (1280 + 64 * (j))
#define XB_XGEN(j)  (2304 + 64 * (j))
#define XB_TOP      3328
#define XB_TOPGEN   3392
#define XCD_BAR_WORDS 3456
#define XB_SPIN_CAP (1u << 18)


__device__ __forceinline__ unsigned xb_ld(unsigned* p)              { return __hip_atomic_load(p, __ATOMIC_RELAXED, __HIP_MEMORY_SCOPE_AGENT); }
__device__ __forceinline__ unsigned xb_add(unsigned* p, unsigned v) { return __hip_atomic_fetch_add(p, v, __ATOMIC_RELAXED, __HIP_MEMORY_SCOPE_AGENT); }
__device__ __forceinline__ unsigned xb_xcc_id() { return (unsigned)__builtin_amdgcn_s_getreg((3 << 11) | 20) & 0xFu; }
#define XB_SPIN(cond, bar) do { unsigned _sp = 0; while (cond) { __builtin_amdgcn_s_sleep(1); \
    if ((++_sp & 255u) == 0u) { if (xb_ld(&(bar)[XB_TMO])) break; if (_sp > XB_SPIN_CAP) { atomicAdd(&(bar)[XB_TMO], 1u); break; } } } } while (0)

struct XcdBarrier {
    unsigned* bar; unsigned x;
    volatile LAS unsigned* st;
};

__device__ __forceinline__ XcdBarrier xcd_barrier_post(unsigned* bar, volatile LAS unsigned* st) {
    XcdBarrier b; b.bar = bar; b.x = xb_xcc_id(); b.st = st;
    if (threadIdx.x == 0) (void)xb_add(&bar[XB_XCNT(b.x)], 1u);
    return b;
}
__device__ __forceinline__ void xcd_barrier_complete(unsigned* bar, unsigned x, unsigned& nloc, unsigned& nx) {
    const unsigned G = gridDim.x * gridDim.y * gridDim.z;
    unsigned sum, cnt, mine, sp = 0u;
    for (;;) {
        sum = 0u; cnt = 0u; mine = 0u;
#pragma unroll
        for (unsigned j = 0; j < 16; ++j) { const unsigned c = xb_ld(&bar[XB_XCNT(j)]); sum += c; cnt += (c > 0u) ? 1u : 0u; mine = (j == x) ? c : mine; }
        if (sum == G) break;
        __builtin_amdgcn_s_sleep(1);
        if ((++sp & 255u) == 0u) { if (xb_ld(&bar[XB_TMO])) break; if (sp > XB_SPIN_CAP) { atomicAdd(&bar[XB_TMO], 1u); break; } }
    }
    nloc = mine > 0u ? mine : 1u; nx = cnt > 0u ? cnt : 1u;
}

__device__ __forceinline__ void xcd_barrier(const XcdBarrier& b, bool is_t0) {
    asm volatile("s_waitcnt vmcnt(0)" ::: "memory");
    __syncthreads();
    if (is_t0) {
        unsigned* bar = b.bar;
        __builtin_amdgcn_s_waitcnt(0);
        unsigned nloc = b.st[0], nx = b.st[1];
        if (nloc == 0u) { xcd_barrier_complete(bar, b.x, nloc, nx); b.st[0] = nloc; b.st[1] = nx; }
        const unsigned old = xb_add(&bar[XB_XSUB(b.x)], 1u);
        const unsigned gen = old / nloc;
        if (old + 1u == (gen + 1u) * nloc) {
            __builtin_amdgcn_fence(__ATOMIC_RELEASE, "agent");
            asm volatile("s_waitcnt vmcnt(0)" ::: "memory");
            const unsigned og = xb_add(&bar[XB_TOP], 1u);
            const unsigned tg = og / nx;
            if (og + 1u == (tg + 1u) * nx) xb_add(&bar[XB_TOPGEN], 1u);
            else XB_SPIN(xb_ld(&bar[XB_TOPGEN]) == tg, bar);
            __builtin_amdgcn_fence(__ATOMIC_ACQUIRE, "agent");
            xb_add(&bar[XB_XGEN(b.x)], 1u);
            asm volatile("s_waitcnt vmcnt(0)" ::: "memory");
        } else {
            XB_SPIN(xb_ld(&bar[XB_XGEN(b.x)]) == gen, bar);
            __builtin_amdgcn_fence(__ATOMIC_ACQUIRE, "agent");
            asm volatile("s_waitcnt vmcnt(0)" ::: "memory");
        }
    }
    __syncthreads();
}


using pg8::bf16_t; using pg8::bf16x8; using pg8::f32x4; using pg8::u32x4;
typedef float f32x16 __attribute__((ext_vector_type(16)));
typedef unsigned u32x2 __attribute__((ext_vector_type(2)));
typedef float f32x2 __attribute__((ext_vector_type(2)));
#define LAS __attribute__((address_space(3)))
#define DI __device__ __forceinline__
#define PARG const __attribute__((address_space(4))) Params*
#define OPAQUE(q) ({ PARG q_ = (q); asm volatile("" : "+s"(q_)); q_; })
#define LF(off)  (*(LAS float*)(lds + (off)))
#define LF2(off) (*(LAS f32x2*)(lds + (off)))
#define LF4(off) (*(LAS f32x4*)(lds + (off)))
#define LH(off)  (*(LAS unsigned short*)(lds + (off)))
#define LU1(off) (*(LAS unsigned*)(lds + (off)))
#define LU2(off) (*(LAS u32x2*)(lds + (off)))
#define LV8(off) (*(LAS bf16x8*)(lds + (off)))
#define LBAR() do { asm volatile("s_waitcnt lgkmcnt(0)" ::: "memory"); __builtin_amdgcn_s_barrier(); asm volatile("" ::: "memory"); } while (0)
#define MFMA32(a, b, c) __builtin_amdgcn_mfma_f32_32x32x16_bf16((a), (b), (c), 0, 0, 0)

constexpr int DM = 1024, NTOK = 16384, NSMP = 128, MROWS = 16512, MPAD = 16640, SEQ = 2048;
constexpr int PW = 4232, NPAD = 4352, BOFF = 2176, BW = 2176;
constexpr int NSUPER = 4, CPS = 8;
constexpr int A_UNIT = 36864, B_UNIT = 28672;
constexpr int LDS_BYTES = 163840;

struct Params {
    const float *x_prompt, *x_sample, *state_a_mat, *state_a_conv, *state_b_mat, *state_b_shift;
    const float *norm_w, *w_in, *conv_w, *a_log, *dt_bias, *a_norm_w, *mu, *w0, *w2, *a0, *a2, *k_k, *k_a, *r_k, *ln_w, *ln_b, *w_out, *final_norm_w;
    float *y, *p_amat, *p_aconv, *p_bmat, *p_bshift, *s_amat, *s_aconv, *s_bmat, *s_bshift;
    bf16_t *xb, *winT, *woutT, *proj, *scanA, *scanB;
    float *glast, *ptb, *bonus, *rowss;
    unsigned* bar;
};

typedef __bf16 bf16x2_t __attribute__((ext_vector_type(2)));
DI unsigned pack2(float lo, float hi) { f32x2 v; v.x = lo; v.y = hi; const bf16x2_t b = __builtin_convertvector(v, bf16x2_t); return __builtin_bit_cast(unsigned, b); }
DI unsigned short f2bf(float f) { return (unsigned short)(pack2(f, 0.f) & 0xffffu); }
DI float bf2f(unsigned short b) { return __uint_as_float(((unsigned)b) << 16); }
DI float bflo(unsigned u) { return __uint_as_float(u << 16); }
DI float bfhi(unsigned u) { return __uint_as_float(u & 0xffff0000u); }
#define DPPF(v, ctrl, rmask, bc) __int_as_float(__builtin_amdgcn_update_dpp(0, __float_as_int(v), (ctrl), (rmask), 0xF, (bc)))
DI float row_sum16(float v) {
    v += DPPF(v, 0xB1, 0xF, true); v += DPPF(v, 0x4E, 0xF, true); v += DPPF(v, 0x141, 0xF, true); v += DPPF(v, 0x140, 0xF, true); return v; }
DI float row_sum8(float v) {
    v += DPPF(v, 0xB1, 0xF, true); v += DPPF(v, 0x4E, 0xF, true); v += DPPF(v, 0x141, 0xF, true); return v; }
DI float wave_sum(float v) {
    v = row_sum16(v); v += DPPF(v, 0x142, 0xA, false); v += DPPF(v, 0x143, 0xC, false);
    return __int_as_float(__builtin_amdgcn_readlane(__float_as_int(v), 63)); }
DI int crow(int i, int h) { return (i & 3) + 8 * (i >> 2) + 4 * h; }
DI int idxA(int row, int k, int KS) { return (((row >> 5) * KS + (k >> 4)) * 64 + ((k >> 3) & 1) * 32 + (row & 31)) * 8 + (k & 7); }
DI float sigmoidf_(float x) { return __builtin_amdgcn_rcpf(1.f + __expf(-x)); }
DI float siluf_(float x) { return x * __builtin_amdgcn_rcpf(1.f + __expf(-x)); }
DI float softplusf_(float x) { return x > 20.f ? x : __logf(1.f + __expf(x)); }
DI float tanhf_(float x) { return 1.f - 2.f * __builtin_amdgcn_rcpf(1.f + __expf(2.f * x)); }
DI f32x16 zero16() { f32x16 r;
#pragma unroll
    for (int i = 0; i < 16; ++i) r[i] = 0.f;
    return r; }
DI f32x16 load_ctile(const bf16_t* base, int tile, int lane) {
    const u32x4* q = (const u32x4*)(base + ((size_t)tile * 64 + lane) * 16); const u32x4 a = q[0], b = q[1]; f32x16 r;
    r[0] = bflo(a.x); r[1] = bfhi(a.x); r[2] = bflo(a.y); r[3] = bfhi(a.y); r[4] = bflo(a.z); r[5] = bfhi(a.z); r[6] = bflo(a.w); r[7] = bfhi(a.w);
    r[8] = bflo(b.x); r[9] = bfhi(b.x); r[10] = bflo(b.y); r[11] = bfhi(b.y); r[12] = bflo(b.z); r[13] = bfhi(b.z); r[14] = bflo(b.w); r[15] = bfhi(b.w);
    return r; }
DI void store_ctile(bf16_t* base, int tile, int lane, const f32x16& v) {
    u32x4* q = (u32x4*)(base + ((size_t)tile * 64 + lane) * 16); u32x4 a, b;
    a.x = pack2(v[0], v[1]); a.y = pack2(v[2], v[3]); a.z = pack2(v[4], v[5]); a.w = pack2(v[6], v[7]);
    b.x = pack2(v[8], v[9]); b.y = pack2(v[10], v[11]); b.z = pack2(v[12], v[13]); b.w = pack2(v[14], v[15]);
    q[0] = a; q[1] = b; }
DI void store_tile_T(LAS unsigned char* lds, int img, int ld, int r0, int c0, const f32x16& v, int lane) {
    const int hh = lane >> 5, l31 = lane & 31;
#pragma unroll
    for (int g = 0; g < 4; ++g) { u32x2 w; w.x = pack2(v[4 * g], v[4 * g + 1]); w.y = pack2(v[4 * g + 2], v[4 * g + 3]);
        LU2(img + ((c0 + l31) * ld + r0 + 8 * g + 4 * hh) * 2) = w; } }


template <int I, int SIGN> DI void tri_row(LAS unsigned char* lds, int MOFF, f32x2 (&xv)[32], f32x4 (&an)[16]) {
    constexpr int n4 = (I + 3) >> 2; f32x4 ac[16];
#pragma unroll
    for (int q = 0; q < n4; ++q) ac[q] = an[q];
    if constexpr (I < 63) { constexpr int n4n = (I + 4) >> 2;
#pragma unroll
        for (int q = 0; q < n4n; ++q) an[q] = LF4(MOFF + ((I + 1) * 68 + 4 * q) * 4); }
    f32x2 s01 = {0.f, 0.f}, s23 = {0.f, 0.f};
#pragma unroll
    for (int q = 0; q < n4; ++q) { const f32x2 a01 = {ac[q][0], ac[q][1]}, a23 = {ac[q][2], ac[q][3]};
        s01 = __builtin_elementwise_fma(a01, xv[2 * q], s01); s23 = __builtin_elementwise_fma(a23, xv[2 * q + 1], s23); }
    const f32x2 s2 = s01 + s23; const float s = s2[0] + s2[1];
    xv[I >> 1][I & 1] = SIGN > 0 ? xv[I >> 1][I & 1] + s : xv[I >> 1][I & 1] - s;
    if constexpr (I < 63) tri_row<I + 1, SIGN>(lds, MOFF, xv, an);
}
template <int SIGN> DI void trisolve64(LAS unsigned char* lds, int MOFF, float (&x)[64]) {
    f32x4 an[16]; f32x2 xv[32];
#pragma unroll
    for (int q = 0; q < 32; ++q) { xv[q][0] = x[2 * q]; xv[q][1] = x[2 * q + 1]; }
    an[0] = LF4(MOFF + 68 * 4);
    tri_row<1, SIGN>(lds, MOFF, xv, an);
#pragma unroll
    for (int q = 0; q < 32; ++q) { x[2 * q] = xv[q][0]; x[2 * q + 1] = xv[q][1]; }
}

DI float quad_sum(float v) {
    v += __int_as_float(__builtin_amdgcn_update_dpp(0, __float_as_int(v), 0xB1, 0xF, 0xF, true));
    v += __int_as_float(__builtin_amdgcn_update_dpp(0, __float_as_int(v), 0x4E, 0xF, 0xF, true));
    return v; }
template <int I, int SIGN> DI void tri_row4p(LAS unsigned char* lrow, int s, f32x2 (&xp)[8]) {
    constexpr int n4 = (I + 3) >> 2, nm = (n4 + 3) >> 2;
    f32x2 p01 = {0.f, 0.f}, p23 = {0.f, 0.f};
#pragma unroll
    for (int m = 0; m < nm; ++m) { const f32x4 a = *(LAS f32x4*)(lrow + (I * 68 + 16 * m) * 4); const f32x2 a01 = {a[0], a[1]}, a23 = {a[2], a[3]};
        p01 = __builtin_elementwise_fma(a01, xp[2 * m], p01); p23 = __builtin_elementwise_fma(a23, xp[2 * m + 1], p23); }
    const f32x2 p2 = p01 + p23; const float tot = quad_sum(p2[0] + p2[1]);
    constexpr int own = (I >> 2) & 3, idx = (I >> 4) * 4 + (I & 3);
    const float xi = SIGN > 0 ? xp[idx >> 1][idx & 1] + tot : xp[idx >> 1][idx & 1] - tot;
    xp[idx >> 1][idx & 1] = (s == own) ? xi : xp[idx >> 1][idx & 1];
    if constexpr (I < 63) tri_row4p<I + 1, SIGN>(lrow, s, xp);
}
template <int I, int SIGN> DI void tri_row4(LAS unsigned char* lrow, int s, float (&xo)[16]) {
    static_assert(I == 1, "entry point"); f32x2 xp[8];
#pragma unroll
    for (int q = 0; q < 8; ++q) { xp[q][0] = xo[2 * q]; xp[q][1] = xo[2 * q + 1]; }
    tri_row4p<1, SIGN>(lrow, s, xp);
#pragma unroll
    for (int q = 0; q < 8; ++q) { xo[2 * q] = xp[q][0]; xo[2 * q + 1] = xp[q][1]; }
}
DI float wave_incl_scan(float v, int lane) {
    v += DPPF(v, 0x111, 0xF, true); v += DPPF(v, 0x112, 0xF, true); v += DPPF(v, 0x114, 0xF, true); v += DPPF(v, 0x118, 0xF, true);
    v += DPPF(v, 0x142, 0xA, false); v += DPPF(v, 0x143, 0xC, false);
    return v; }

struct EpiProj {
    static constexpr bool PERM = true, AFTER_DRAIN = false;
    bf16_t* O; int ldc;
    __device__ __forceinline__ void operator()(const f32x4 (&acc)[2][2][4][2], const pg8::Unit& u, int wr, int wc, int fr, int fq) const {
        const int row0 = u.pm * 256 + wr * 64 + fr, col0 = u.pn * 256 + wc * 32 + 8 * fq;
#pragma unroll
        for (int ai = 0; ai < 2; ++ai)
#pragma unroll
            for (int m = 0; m < 4; ++m) { bf16_t* rowp = O + (size_t)(row0 + ai * 128 + m * 16) * ldc + col0;
#pragma unroll
                for (int bj = 0; bj < 2; ++bj) { const f32x4 v0 = acc[ai][bj][m][0], v1 = acc[ai][bj][m][1];
                    u32x4 w; w.x = pack2(v0[0], v0[1]); w.y = pack2(v0[2], v0[3]); w.z = pack2(v1[0], v1[1]); w.w = pack2(v1[2], v1[3]);
                    *(u32x4*)(rowp + bj * 128) = w; } }
    }
};
struct EpiOut {
    static constexpr bool PERM = false, AFTER_DRAIN = false;
    const float* xp; const float* xs; float* out; float* rowss;
    __device__ __forceinline__ void operator()(const f32x4 (&acc)[2][2][4][2], const pg8::Unit& u, int wr, int wc, int fr, int fq) const {
        const int row0 = u.pm * 256 + wr * 64 + fr, col0 = u.pn * 256 + wc * 32 + 4 * fq;
#pragma unroll
        for (int ai = 0; ai < 2; ++ai)
#pragma unroll
            for (int m = 0; m < 4; ++m) { const int r = row0 + ai * 128 + m * 16; const bool valid = r < MROWS; float ss = 0.f;
                if (valid) { const float* xr = r < NTOK ? xp + (size_t)r * DM : xs + (size_t)(r - NTOK) * DM; float* orow = out + (size_t)r * DM;
#pragma unroll
                    for (int bj = 0; bj < 2; ++bj)
#pragma unroll
                        for (int n = 0; n < 2; ++n) { const int c = col0 + bj * 128 + n * 16; const f32x4 hv = *(const f32x4*)(xr + c) + acc[ai][bj][m][n];
                            *(f32x4*)(orow + c) = hv; ss += hv[0] * hv[0] + hv[1] * hv[1] + hv[2] * hv[2] + hv[3] * hv[3]; } }
                ss += __shfl_xor(ss, 16); ss += __shfl_xor(ss, 32);
                if (valid && fq == 0) rowss[(size_t)r * 16 + u.pn * 4 + wc] = ss; }
    }
};

struct OneUnit { int pm, pn;
    __device__ __forceinline__ bool next(int i, pg8::Unit& u) const { if (i > 0) return false; u.pm = pm; u.pn = pn; return true; }
    __device__ __forceinline__ void a_ready(const pg8::Unit&) const {}
    __device__ __forceinline__ void done(const pg8::Unit&) const {}
};

DI void phase0(int tidx, PARG p, LAS unsigned char* lds) {
    int tid_ = tidx; asm volatile("" : "+v"(tid_)); const int tid = tid_, lane = tid & 63, wid = __builtin_amdgcn_readfirstlane(tid >> 6);
    {
        const int stride = gridDim.x * 8; f32x4 nw[4];
#pragma unroll
        for (int i = 0; i < 4; ++i) nw[i] = *(const f32x4*)(p->norm_w + i * 256 + lane * 4);
        for (int row0 = blockIdx.x * 8 + wid; row0 < MPAD; row0 += 4 * stride) {
            f32x4 v[4][4];
#pragma unroll
            for (int r = 0; r < 4; ++r) { const int row = row0 + r * stride;
                if (row < MROWS) { const float* src = row < NTOK ? p->x_prompt + (size_t)row * DM : p->x_sample + (size_t)(row - NTOK) * DM;
#pragma unroll
                    for (int i = 0; i < 4; ++i) v[r][i] = *(const f32x4*)(src + i * 256 + lane * 4);
                } else {
#pragma unroll
                    for (int i = 0; i < 4; ++i) v[r][i] = (f32x4){0.f, 0.f, 0.f, 0.f}; } }
#pragma unroll
            for (int r = 0; r < 4; ++r) { const int row = row0 + r * stride;
                if (row < MPAD) { float ss = 0.f;
#pragma unroll
                    for (int i = 0; i < 4; ++i) ss += v[r][i][0] * v[r][i][0] + v[r][i][1] * v[r][i][1] + v[r][i][2] * v[r][i][2] + v[r][i][3] * v[r][i][3];
                    ss = wave_sum(ss); const float rs = rsqrtf(ss * (1.f / 1024.f) + 1e-6f); bf16_t* dst = p->xb + (size_t)row * DM;
#pragma unroll
                    for (int i = 0; i < 4; ++i) { u32x2 w; w.x = pack2(v[r][i][0] * rs * nw[i][0], v[r][i][1] * rs * nw[i][1]); w.y = pack2(v[r][i][2] * rs * nw[i][2], v[r][i][3] * rs * nw[i][3]);
                        *(u32x2*)(dst + i * 256 + lane * 4) = w; } } }
        }
    }
    for (int t = blockIdx.x; t < 16 * 68 + 16 * 16; t += gridDim.x) {
        const bool isout = t >= 1088; const int tt = isout ? t - 1088 : t; const int nts = isout ? 16 : 68; const int kt = tt / nts, nt = tt % nts;
        const float* W = isout ? p->w_out : p->w_in; const int ldw = isout ? 1024 : PW; bf16_t* dstT = isout ? p->woutT : p->winT;
#pragma unroll
        for (int i = 0; i < 8; ++i) { const int e = tid + 512 * i, kk = e >> 6, nn = e & 63, n = nt * 64 + nn;
            const int sc = isout ? n : (n < 2056 ? n : (n < BOFF ? -1 : n - 120));
            LF((kk * 65 + nn) * 4) = sc >= 0 ? W[(size_t)(kt * 64 + kk) * ldw + sc] : 0.f; }
        __syncthreads();
#pragma unroll
        for (int i = 0; i < 4; ++i) { const int e = tid + 512 * i, nn = e >> 5, kp = e & 31;
            *(unsigned*)(dstT + (size_t)(nt * 64 + nn) * DM + kt * 64 + 2 * kp) = pack2(LF(((2 * kp) * 65 + nn) * 4), LF(((2 * kp + 1) * 65 + nn) * 4)); }
        __syncthreads();
    }
}

DI void lds_copy_out(LAS unsigned char* lds, int lds_off, bf16_t* dst, int bytes, int tid) {
    for (int o = tid * 16; o < bytes; o += 512 * 16) *(u32x4*)((unsigned char*)dst + o) = *(LAS u32x4*)(lds + lds_off + o);
}
DI void p2a_unit(int tidx, PARG p, LAS unsigned char* lds, int b, int h, int chunk, int ua) {
    int tid_ = tidx; asm volatile("" : "+v"(tid_)); const int tid = tid_, lane = tid & 63, wid = __builtin_amdgcn_readfirstlane(tid >> 6), hh = lane >> 5, l31 = lane & 31;
    constexpr int AM = 0, GS = 17408, QB = 18432, KB = 35840, KF = 53248, VF = 86016, QKS = 118784, QGS = 126976, KDS = 143360, WS = KB, US = VF;
    bf16_t* base = p->scanA + (size_t)ua * A_UNIT;
    const int t0 = chunk * 64;
    {
        const int cq = h * 128 + lane * 2;
        float cw[3][4][2];
#pragma unroll
        for (int g3 = 0; g3 < 3; ++g3)
#pragma unroll
            for (int i = 0; i < 4; ++i) { const float* pw = p->conv_w + i * 1536 + g3 * 512 + cq; cw[g3][i][0] = pw[0]; cw[g3][i][1] = pw[1]; }
        unsigned raw[11][3];
#pragma unroll
        for (int r = 0; r < 11; ++r) { const int ts = t0 + wid * 8 - 3 + r;
            if (ts >= 0) { const bf16_t* pr = p->proj + (size_t)(b * SEQ + ts) * NPAD + cq;
#pragma unroll
                for (int g3 = 0; g3 < 3; ++g3) raw[r][g3] = *(const unsigned*)(pr + g3 * 512);
            } else { raw[r][0] = 0u; raw[r][1] = 0u; raw[r][2] = 0u; } }
        float bg = 0.f, gg = 0.f;
        if (lane < 8) { const bf16_t* pr = p->proj + (size_t)(b * SEQ + t0 + wid * 8 + lane) * NPAD; bg = sigmoidf_(bf2f(pr[2048 + h]));
            gg = -__expf(p->a_log[h]) * softplusf_(bf2f(pr[2052 + h]) + p->dt_bias[h]); }
#pragma unroll
        for (int rr = 0; rr < 8; ++rr) {
            const int i = wid * 8 + rr; float o[3][2];
#pragma unroll
            for (int g3 = 0; g3 < 3; ++g3) { o[g3][0] = 0.f; o[g3][1] = 0.f;
#pragma unroll
                for (int tap = 0; tap < 4; ++tap) { const unsigned u = raw[rr + tap][g3]; o[g3][0] += bflo(u) * cw[g3][tap][0]; o[g3][1] += bfhi(u) * cw[g3][tap][1]; } }
            float q0 = siluf_(o[0][0]), q1 = siluf_(o[0][1]), k0 = siluf_(o[1][0]), k1 = siluf_(o[1][1]); const float v0 = siluf_(o[2][0]), v1 = siluf_(o[2][1]);
            const float sq = wave_sum(q0 * q0 + q1 * q1), sk = wave_sum(k0 * k0 + k1 * k1);
            const float rq = rsqrtf(sq + 1e-12f) * 0.08838834764831845f, rk = rsqrtf(sk + 1e-12f);
            q0 *= rq; q1 *= rq; k0 *= rk; k1 *= rk;
            LU1(QB + (i * 136 + lane * 2) * 2) = pack2(q0, q1); LU1(KB + (i * 136 + lane * 2) * 2) = pack2(k0, k1);
            f32x2 kf; kf.x = k0; kf.y = k1; LF2(KF + (i * 128 + lane * 2) * 4) = kf; f32x2 vf; vf.x = v0; vf.y = v1; LF2(VF + (i * 128 + lane * 2) * 4) = vf;
        }
        if (lane < 8) { LF(GS + (wid * 8 + lane) * 4) = gg; LF(GS + 256 + (wid * 8 + lane) * 4) = bg; }
    }
    LBAR();
    if (tid < 64) { const float Gi = wave_incl_scan(LF(GS + tid * 4), lane); const float GLs = __int_as_float(__builtin_amdgcn_readlane(__float_as_int(Gi), 63));
        LF(GS + 512 + tid * 4) = Gi; LF(GS + tid * 4) = __expf(Gi); LF(GS + 768 + tid * 4) = __expf(GLs - Gi); }
    LBAR();
    {
        const int mat = wid >> 2, tile = wid & 3, it = tile >> 1, jt = tile & 1;
        f32x16 acc = zero16();
        const int aoff = (mat ? QB : KB) + ((it * 32 + l31) * 136 + 8 * hh) * 2, boff = KB + ((jt * 32 + l31) * 136 + 8 * hh) * 2;
#pragma unroll
        for (int s = 0; s < 8; ++s) acc = MFMA32(LV8(aoff + s * 32), LV8(boff + s * 32), acc);
        const int j = jt * 32 + l31; const float Gj = LF(GS + 512 + j * 4);
        if (mat == 0) {
#pragma unroll
            for (int ii = 0; ii < 16; ++ii) { const int i = it * 32 + crow(ii, hh); const float Gi = LF(GS + 512 + i * 4); const float dec = __expf(fminf(Gi - Gj, 0.f));
                const float bi = LF(GS + 256 + i * 4); LF(AM + (i * 68 + j) * 4) = (j < i) ? bi * dec * acc[ii] : 0.f; }
        } else {
#pragma unroll
            for (int ii = 0; ii < 16; ++ii) { const int i = it * 32 + crow(ii, hh); const float Gi = LF(GS + 512 + i * 4); const float dec = __expf(fminf(Gi - Gj, 0.f));
                LH(QKS + idxA(i, j, 4) * 2) = f2bf((j <= i) ? dec * acc[ii] : 0.f); }
        }
    }
    LBAR();
    float x[64];
    const int c = tid;
    if (tid < 256) {
        LAS unsigned char* lcol = lds + (c < 128 ? KF + c * 4 : VF + (c - 128) * 4); asm volatile("" : "+v"(lcol));
#pragma unroll
        for (int j = 0; j < 64; ++j) x[j] = *(LAS float*)(lcol + j * 512);
#pragma unroll
        for (int j4 = 0; j4 < 16; ++j4) { const f32x4 bv = LF4(GS + 256 + j4 * 16), gv = LF4(GS + j4 * 16);
#pragma unroll
            for (int k = 0; k < 4; ++k) x[4 * j4 + k] *= (c < 128) ? bv[k] * gv[k] : bv[k]; }
    }
    LBAR();
    if (tid < 256) {
        trisolve64<-1>(lds, AM, x);
        if (c < 128) {
#pragma unroll
            for (int i = 0; i < 64; i += 2) { const unsigned u = pack2(x[i], x[i + 1]); LH(WS + idxA(i, c, 8) * 2) = (unsigned short)u; LH(WS + idxA(i + 1, c, 8) * 2) = (unsigned short)(u >> 16); }
        } else { const int v = c - 128;
#pragma unroll
            for (int m = 0; m < 16; ++m) {
                const int tile = (m >> 3) * 4 + (v >> 5), hh2 = m & 1, ii0 = 4 * ((m & 7) >> 1), ln = (v & 31) + 32 * hh2;
                u32x2 w; w.x = pack2(x[4 * m], x[4 * m + 1]); w.y = pack2(x[4 * m + 2], x[4 * m + 3]);
                LU2(US + ((tile * 64 + ln) * 16 + ii0) * 2) = w; }
        }
    } else {
        const int t2 = tid - 256; const float GL = LF(GS + 512 + 63 * 4);
#pragma unroll
        for (int m = 0; m < 4; ++m) { const int item = t2 + 256 * m, i = item >> 4, g8 = item & 15; const float e = LF(GS + i * 4);
            const bf16x8 q8 = LV8(QB + (i * 136 + g8 * 8) * 2); u32x4 w;
            w.x = pack2(bf2f((unsigned short)q8[0]) * e, bf2f((unsigned short)q8[1]) * e); w.y = pack2(bf2f((unsigned short)q8[2]) * e, bf2f((unsigned short)q8[3]) * e);
            w.z = pack2(bf2f((unsigned short)q8[4]) * e, bf2f((unsigned short)q8[5]) * e); w.w = pack2(bf2f((unsigned short)q8[6]) * e, bf2f((unsigned short)q8[7]) * e);
            *(LAS u32x4*)(lds + QGS + idxA(i, g8 * 8, 8) * 2) = w; }
#pragma unroll
        for (int m = 0; m < 4; ++m) { const int item = t2 + 256 * m, cc = item & 127, g = item >> 7; const f32x4 e0 = LF4(GS + 768 + g * 32), e1 = LF4(GS + 768 + g * 32 + 16);
            float kv[8];
#pragma unroll
            for (int k = 0; k < 8; ++k) kv[k] = LF(KF + ((8 * g + k) * 128 + cc) * 4);
            u32x4 w; w.x = pack2(kv[0] * e0[0], kv[1] * e0[1]); w.y = pack2(kv[2] * e0[2], kv[3] * e0[3]); w.z = pack2(kv[4] * e1[0], kv[5] * e1[1]); w.w = pack2(kv[6] * e1[2], kv[7] * e1[3]);
            *(LAS u32x4*)(lds + KDS + idxA(cc, 8 * g, 4) * 2) = w; }
        if (t2 == 0) p->glast[ua] = __expf(GL);
    }
    LBAR();
    lds_copy_out(lds, WS, base, 16384, tid); lds_copy_out(lds, US, base + 8192, 16384, tid); lds_copy_out(lds, QKS, base + 16384, 40960, tid);
    LBAR();
}

DI void p2b_unit(int tidx, PARG p, LAS unsigned char* lds, int b, int h, int chunk, int ub) {
    int tid_ = tidx; asm volatile("" : "+v"(tid_)); const int tid = tid_, lane = tid & 63, wid = __builtin_amdgcn_readfirstlane(tid >> 6), hh = lane >> 5, l31 = lane & 31;
    constexpr int W2T = 0, A2T = 9216, TW = 18432, AD = 27648, LAs = 36864, LPs = 53248;
    constexpr int MS = 0, MAKB = 17408, NRKB = 26624, MVF = 35840;
    constexpr int AHB = 69632, BHB = 78848, KHB = 88064, RHB = 97280, VT = 106496, KTT = 115712;
    constexpr int RHS = 124928, BTS = 133120, NRBS = 141312, W2S = RHS, U2S = BTS, AHT = 149504, MVT = 35840, TIA = 45056;
    bf16_t* base = p->scanB + (size_t)ub * B_UNIT; bf16_t* Y0g = base + 20480; bf16_t* KVg = base + 24576;
#pragma unroll
    for (int m = 0; m < 8; ++m) { const int e = tid + 512 * m, l = e >> 6, ch = e & 63;
        LH(W2T + (ch * 72 + l) * 2) = f2bf(p->w2[l * 512 + h * 64 + ch]); LH(A2T + (ch * 72 + l) * 2) = f2bf(p->a2[l * 512 + h * 64 + ch]); }
    float r_[8], kr_[8], v_[8];
    {
        const int cols[5] = {h * 64 + lane, 512 + h * 64 + lane, 1024 + h * 64 + lane, 2048 + lane, 2112 + lane};
        float mu5[5]; unsigned short raw[9][5];
#pragma unroll
        for (int q = 0; q < 5; ++q) mu5[q] = p->mu[cols[q]];
#pragma unroll
        for (int r = 0; r < 9; ++r) { const int tg = chunk * 64 + wid * 8 - 1 + r;
            if (tg >= 0) { const bf16_t* pc = p->proj + (size_t)(b * SEQ + tg) * NPAD + BOFF;
#pragma unroll
                for (int q = 0; q < 5; ++q) raw[r][q] = pc[cols[q]];
            } else {
#pragma unroll
                for (int q = 0; q < 5; ++q) raw[r][q] = 0; } }
#pragma unroll
        for (int rr = 0; rr < 8; ++rr) { const int t = wid * 8 + rr; float sh[5];
#pragma unroll
            for (int q = 0; q < 5; ++q) { const float cur = bf2f(raw[rr + 1][q]), prv = bf2f(raw[rr][q]); sh[q] = cur + (prv - cur) * mu5[q]; }
            r_[rr] = sh[0]; kr_[rr] = sh[1]; v_[rr] = sh[2];
            LH(TW + (t * 72 + lane) * 2) = f2bf(tanhf_(sh[3])); LH(AD + (t * 72 + lane) * 2) = f2bf(sh[4]); }
    }
    LBAR();
    {
        const int mat = wid >> 2, tile = wid & 3, it = tile >> 1, jt = tile & 1;
        f32x16 acc = zero16();
        const int aoff = (mat ? AD : TW) + ((it * 32 + l31) * 72 + 8 * hh) * 2, boff = (mat ? A2T : W2T) + ((jt * 32 + l31) * 72 + 8 * hh) * 2;
#pragma unroll
        for (int s = 0; s < 4; ++s) acc = MFMA32(LV8(aoff + s * 32), LV8(boff + s * 32), acc);
        const int ch = jt * 32 + l31; const float bias = mat ? p->a0[h * 64 + ch] : p->w0[h * 64 + ch];
        const float ofac = mat ? 1.f : -0.6065306597126334f; const int obase = mat ? LAs : LPs;
#pragma unroll
        for (int ii = 0; ii < 16; ++ii) { const int t = it * 32 + crow(ii, hh); const float z = bias + acc[ii];
            LF(obase + (t * 64 + ch) * 4) = ofac * sigmoidf_(z); }
    }
    LBAR();
#pragma unroll
    for (int q = 0; q < 8; ++q) { const int ch = wid * 8 + q; LF(LPs + (lane * 64 + ch) * 4) = wave_incl_scan(LF(LPs + (lane * 64 + ch) * 4), lane); }
    LBAR();
    {
        const int ch = lane; const float kkw = p->k_k[h * 64 + ch], kaw = p->k_a[h * 64 + ch], rkw = p->r_k[h * 64 + ch]; const float lpT = LF(LPs + (63 * 64 + ch) * 4); const float PT = __expf(lpT); float Pprev = 1.f;
#pragma unroll
        for (int rp = 0; rp < 4; ++rp) {
            const int t = wid * 8 + 2 * rp;
            f32x2 a, lp, r, kr, vv; a[0] = LF(LAs + (t * 64 + ch) * 4); a[1] = LF(LAs + ((t + 1) * 64 + ch) * 4); lp[0] = LF(LPs + (t * 64 + ch) * 4); lp[1] = LF(LPs + ((t + 1) * 64 + ch) * 4);
            r[0] = r_[2 * rp]; r[1] = r_[2 * rp + 1]; kr[0] = kr_[2 * rp]; kr[1] = kr_[2 * rp + 1]; vv[0] = v_[2 * rp]; vv[1] = v_[2 * rp + 1];
            const f32x2 kkv = kr * kkw, sq = kkv * kkv; f32x2 rs; rs[0] = rsqrtf(wave_sum(sq[0]) + 1e-12f); rs[1] = rsqrtf(wave_sum(sq[1]) + 1e-12f);
            const f32x2 kk = kkv * rs, kmod = kr * ((a - 1.f) * kaw + 1.f), bw = r * kmod * rkw;
            const float bon0 = wave_sum(bw[0]), bon1 = wave_sum(bw[1]);
            if (lane == 0) { float* bp = p->bonus + (size_t)(b * SEQ + chunk * 64 + t) * 8 + h; bp[0] = bon0; bp[8] = bon1; }
            f32x2 P, Pi; P[0] = __expf(lp[0]); P[1] = __expf(lp[1]); Pi[0] = __builtin_amdgcn_rcpf(P[0]); Pi[1] = __builtin_amdgcn_rcpf(P[1]);
            f32x2 Pp; Pp[0] = rp == 0 ? __expf(t > 0 ? LF(LPs + ((t - 1) * 64 + ch) * 4) : 0.f) : Pprev; Pp[1] = P[0]; Pprev = P[1];
            const f32x2 Pt = Pi * PT, ka = kk * a, Ah = -(kk * Pp), Bh = ka * Pi, Kh = kmod * Pi, Rh = r * P, Bt = ka * Pt, Kt = kmod * Pt;
            const unsigned uA = pack2(Ah[0], Ah[1]), uB = pack2(Bh[0], Bh[1]), uK = pack2(Kh[0], Kh[1]), uR = pack2(Rh[0], Rh[1]);
            LH(AHB + (t * 72 + ch) * 2) = (unsigned short)uA; LH(AHB + ((t + 1) * 72 + ch) * 2) = (unsigned short)(uA >> 16);
            LH(BHB + (t * 72 + ch) * 2) = (unsigned short)uB; LH(BHB + ((t + 1) * 72 + ch) * 2) = (unsigned short)(uB >> 16);
            LH(KHB + (t * 72 + ch) * 2) = (unsigned short)uK; LH(KHB + ((t + 1) * 72 + ch) * 2) = (unsigned short)(uK >> 16);
            LH(RHB + (t * 72 + ch) * 2) = (unsigned short)uR; LH(RHB + ((t + 1) * 72 + ch) * 2) = (unsigned short)(uR >> 16);
            LH(RHS + idxA(t, ch, 4) * 2) = (unsigned short)uR; LH(RHS + idxA(t + 1, ch, 4) * 2) = (unsigned short)(uR >> 16);
            LU1(VT + (ch * 72 + t) * 2) = pack2(vv[0], vv[1]); LU1(KTT + (ch * 72 + t) * 2) = pack2(Kt[0], Kt[1]); LU1(AHT + (ch * 72 + t) * 2) = uA;
            LU1(BTS + idxA(ch, t, 4) * 2) = pack2(Bt[0], Bt[1]);
        }
        if (wid == 7) p->ptb[(size_t)ub * 64 + ch] = PT;
    }
    LBAR();
#pragma unroll
    for (int q = 0; q < 2; ++q) {
        const int tileid = 2 * wid + q, mat = tileid >> 2, tl = tileid & 3, it = tl >> 1, jt = tl & 1;
        f32x16 acc = zero16();
        const int aoff = ((mat >= 2) ? RHB : AHB) + ((it * 32 + l31) * 72 + 8 * hh) * 2, boff = ((mat & 1) ? KHB : BHB) + ((jt * 32 + l31) * 72 + 8 * hh) * 2;
#pragma unroll
        for (int s = 0; s < 4; ++s) acc = MFMA32(LV8(aoff + s * 32), LV8(boff + s * 32), acc);
        const int j = jt * 32 + l31;
        if (mat == 0) {
#pragma unroll
            for (int ii = 0; ii < 16; ++ii) { const int i = it * 32 + crow(ii, hh); LF(MS + (i * 68 + j) * 4) = (j < i) ? acc[ii] : 0.f; }
        } else if (mat == 1) {
#pragma unroll
            for (int ii = 0; ii < 16; ++ii) { const int i = it * 32 + crow(ii, hh); LH(MAKB + (i * 72 + j) * 2) = f2bf((j < i) ? acc[ii] : 0.f); }
        } else if (mat == 2) {
#pragma unroll
            for (int ii = 0; ii < 16; ++ii) { const int i = it * 32 + crow(ii, hh); LH(NRBS + idxA(i, j, 4) * 2) = f2bf((j <= i) ? acc[ii] : 0.f); }
        } else {
#pragma unroll
            for (int ii = 0; ii < 16; ++ii) { const int i = it * 32 + crow(ii, hh); LH(NRKB + (i * 72 + j) * 2) = f2bf((j <= i) ? acc[ii] : 0.f); }
        }
    }
    LBAR();
    lds_copy_out(lds, RHS, base, 24576, tid);
    {
        const int mat = wid >> 2, tl = wid & 3, it = tl >> 1, jt = tl & 1;
        f32x16 acc = zero16();
        const int aoff = (mat ? NRKB : MAKB) + ((it * 32 + l31) * 72 + 8 * hh) * 2, boff = VT + ((jt * 32 + l31) * 72 + 8 * hh) * 2;
#pragma unroll
        for (int s = 0; s < 4; ++s) acc = MFMA32(LV8(aoff + s * 32), LV8(boff + s * 32), acc);
        if (mat == 0) store_tile_T(lds, MVT, 72, it * 32, jt * 32, acc, lane);
        else store_ctile(Y0g, it * 2 + jt, lane, acc);
        if (wid < 4) { f32x16 a2 = zero16(); const int ao2 = KTT + ((it * 32 + l31) * 72 + 8 * hh) * 2;
#pragma unroll
            for (int s = 0; s < 4; ++s) a2 = MFMA32(LV8(ao2 + s * 32), LV8(boff + s * 32), a2);
            store_ctile(KVg, it * 2 + jt, lane, a2); }
    }
    LBAR();
    if (tid < 256) {
        const int c = tid >> 2, s = tid & 3; float xo[16];
#pragma unroll
        for (int k = 0; k < 16; ++k) xo[k] = (16 * (k >> 2) + 4 * s + (k & 3) == c) ? 1.f : 0.f;
        LAS unsigned char* lrow = lds + MS + 16 * s; asm volatile("" : "+v"(lrow));
        tri_row4<1, 1>(lrow, s, xo);
#pragma unroll
        for (int k = 0; k < 16; k += 2) { const unsigned u = pack2(xo[k], xo[k + 1]); const int j0 = 16 * (k >> 2) + 4 * s + (k & 3);
            LH(TIA + (j0 * 72 + c) * 2) = (unsigned short)u; LH(TIA + ((j0 + 1) * 72 + c) * 2) = (unsigned short)(u >> 16); }
    }
    LBAR();
    {
        const int mat = wid >> 2, tl = wid & 3, it = tl >> 1, jt = tl & 1;
        f32x16 acc = zero16();
        const int aoff = TIA + ((it * 32 + l31) * 72 + 8 * hh) * 2, boff = (mat ? MVT : AHT) + ((jt * 32 + l31) * 72 + 8 * hh) * 2;
#pragma unroll
        for (int s = 0; s < 4; ++s) acc = MFMA32(LV8(aoff + s * 32), LV8(boff + s * 32), acc);
        if (mat == 0) {
#pragma unroll
            for (int ii = 0; ii < 16; ++ii) LH(W2S + idxA(it * 32 + crow(ii, hh), jt * 32 + l31, 4) * 2) = f2bf(acc[ii]);
        } else { u32x4 a, b2;
            a.x = pack2(acc[0], acc[1]); a.y = pack2(acc[2], acc[3]); a.z = pack2(acc[4], acc[5]); a.w = pack2(acc[6], acc[7]);
            b2.x = pack2(acc[8], acc[9]); b2.y = pack2(acc[10], acc[11]); b2.z = pack2(acc[12], acc[13]); b2.w = pack2(acc[14], acc[15]);
            *(LAS u32x4*)(lds + U2S + ((it * 2 + jt) * 64 + lane) * 32) = a; *(LAS u32x4*)(lds + U2S + ((it * 2 + jt) * 64 + lane) * 32 + 16) = b2; }
    }
    LBAR();
    lds_copy_out(lds, W2S, base + 12288, 16384, tid);
    LBAR();
}

DI void dma_pieces(LAS unsigned char* lds, int lds_off, const bf16_t* g, int first, int n, int w, int nw, int lane) {
    for (int q = first + w; q < first + n; q += nw)
        __builtin_amdgcn_global_load_lds((const unsigned*)((const char*)g + q * 1024 + lane * 16), (LAS unsigned*)(lds + lds_off + q * 1024), 16, 0, 0);
}
DI void dma_one(LAS unsigned char* lds, int lds_byte, const void* gbyte, int lane) {
    __builtin_amdgcn_global_load_lds((const unsigned*)((const char*)gbyte + lane * 16), (LAS unsigned*)(lds + lds_byte), 16, 0, 0);
}
DI f32x16 expand16(const u32x4& a, const u32x4& b) { f32x16 r;
    r[0] = bflo(a.x); r[1] = bfhi(a.x); r[2] = bflo(a.y); r[3] = bfhi(a.y); r[4] = bflo(a.z); r[5] = bfhi(a.z); r[6] = bflo(a.w); r[7] = bfhi(a.w);
    r[8] = bflo(b.x); r[9] = bfhi(b.x); r[10] = bflo(b.y); r[11] = bfhi(b.y); r[12] = bflo(b.z); r[13] = bfhi(b.z); r[14] = bflo(b.w); r[15] = bfhi(b.w);
    return r; }
#define WAIT_VM0() asm volatile("s_waitcnt vmcnt(0)" ::: "memory")
#define WAIT_VM4() asm volatile("s_waitcnt vmcnt(4)" ::: "memory")
#define MEMBAR() asm volatile("" ::: "memory")

DI void scanA(int tidx, PARG p, LAS unsigned char* lds, int bh, int sst, bool dry = false) {
    int tid_ = tidx; asm volatile("" : "+v"(tid_)); const int tid = tid_, lane = tid & 63, wid = __builtin_amdgcn_readfirstlane(tid >> 6), hh = lane >> 5, l31 = lane & 31;
    const int b = bh >> 2, h = bh & 3; const int vt = wid & 3, ct = wid >> 2, kt0 = 2 * (wid >> 2);
    constexpr int ST = 0, UT = 34816, OT = 53248, WQ = 70656, QKD = 136192;
    float* Sg = p->p_amat + (size_t)bh * 16384;
    const bf16_t* gb = p->scanA + (size_t)bh * CPS * A_UNIT;
    const char* gbc = (const char*)gb;
    dma_pieces(lds, WQ, gb, 0, 16, wid, 8, lane);
    for (int q = wid; q < 16; q += 8) dma_one(lds, WQ + 16384 + q * 1024, gbc + 40960 + q * 1024, lane);
    for (int q = wid; q < 24; q += 8) dma_one(lds, QKD + q * 1024, gbc + (q < 8 ? 32768 + q * 1024 : 57344 + (q - 8) * 1024), lane);
    const u32x4* ug = (const u32x4*)(gbc + 16384 + ((ct * 4 + vt) * 64 + lane) * 32);
    u32x4 uc0 = ug[0], uc1 = ug[1];
    f32x16 S0 = zero16(), S1 = zero16();
    if (sst > 0) {
#pragma unroll
        for (int ii = 0; ii < 16; ++ii) { S0[ii] = Sg[(kt0 * 32 + crow(ii, hh)) * 128 + vt * 32 + l31]; S1[ii] = Sg[((kt0 + 1) * 32 + crow(ii, hh)) * 128 + vt * 32 + l31]; }
    }
    store_tile_T(lds, ST, 136, kt0 * 32, vt * 32, S0, lane); store_tile_T(lds, ST, 136, kt0 * 32 + 32, vt * 32, S1, lane);
    const int cg = tid & 15, rowA = tid >> 4;
    float anw[8];
#pragma unroll
    for (int k = 0; k < 8; ++k) anw[k] = p->a_norm_w[cg * 8 + k];
    WAIT_VM0();
    __syncthreads();
    for (int nl = 0; nl < CPS; ++nl) {
        const int chunk = sst * CPS + nl, ua = bh * CPS + nl; const bool more = nl + 1 < CPS;
        const char* gn = gbc + (size_t)(nl + 1) * (A_UNIT * 2);
        const int wq = WQ + (nl & 1) * 32768, wqn = WQ + ((nl + 1) & 1) * 32768;
        if (tid == 0) __hip_atomic_store(p->bar + XCD_BAR_WORDS + 64 * bh, (unsigned)(chunk + 1), __ATOMIC_RELAXED, __HIP_MEMORY_SCOPE_AGENT);
        const float gl = p->glast[ua];
        const size_t tok0 = (size_t)b * SEQ + chunk * 64 + rowA;
        const u32x4 gate0 = *(const u32x4*)(p->proj + tok0 * NPAD + 1536 + h * 128 + cg * 8), gate1 = *(const u32x4*)(p->proj + (tok0 + 32) * NPAD + 1536 + h * 128 + cg * 8);
        u32x4 un0 = uc0, un1 = uc1;
        if (more) { const u32x4* un = (const u32x4*)(gn + 16384 + ((ct * 4 + vt) * 64 + lane) * 32); un0 = un[0]; un1 = un[1]; }
        MEMBAR();
        if (more) {
            dma_one(lds, wqn + wid * 1024, gn + wid * 1024, lane); dma_one(lds, wqn + (wid + 8) * 1024, gn + (wid + 8) * 1024, lane);
            dma_one(lds, wqn + 16384 + wid * 1024, gn + 40960 + wid * 1024, lane); dma_one(lds, wqn + 16384 + (wid + 8) * 1024, gn + 40960 + (wid + 8) * 1024, lane); }
        MEMBAR();
        f32x16 au = zero16(), ao = zero16();
#pragma unroll
        for (int s = 0; s < 8; ++s) { const bf16x8 bS = LV8(ST + ((vt * 32 + l31) * 136 + s * 16 + 8 * hh) * 2);
            const bf16x8 aW = LV8(wq + ((ct * 8 + s) * 64 + lane) * 16), aQ = LV8(wq + 16384 + ((ct * 8 + s) * 64 + lane) * 16);
            au = MFMA32(aW, bS, au); ao = MFMA32(aQ, bS, ao); }
        { const f32x16 uc = expand16(uc0, uc1);
#pragma unroll
          for (int ii = 0; ii < 16; ++ii) au[ii] = uc[ii] - au[ii]; }
        store_tile_T(lds, UT, 72, ct * 32, vt * 32, au, lane);
        if (more) WAIT_VM4(); else WAIT_VM0();
        __syncthreads();
#pragma unroll
        for (int ii = 0; ii < 16; ++ii) { S0[ii] *= gl; S1[ii] *= gl; }
#pragma unroll
        for (int s = 0; s < 4; ++s) { const bf16x8 bU = LV8(UT + ((vt * 32 + l31) * 72 + s * 16 + 8 * hh) * 2);
            const bf16x8 aQK = LV8(QKD + ((ct * 4 + s) * 64 + lane) * 16);
            const bf16x8 aK0 = LV8(QKD + 8192 + ((kt0 * 4 + s) * 64 + lane) * 16), aK1 = LV8(QKD + 8192 + (((kt0 + 1) * 4 + s) * 64 + lane) * 16);
            ao = MFMA32(aQK, bU, ao); S0 = MFMA32(aK0, bU, S0); S1 = MFMA32(aK1, bU, S1); }
#pragma unroll
        for (int ii = 0; ii < 16; ++ii) LH(OT + ((ct * 32 + crow(ii, hh)) * 136 + vt * 32 + l31) * 2) = f2bf(ao[ii]);
        store_tile_T(lds, ST, 136, kt0 * 32, vt * 32, S0, lane); store_tile_T(lds, ST, 136, kt0 * 32 + 32, vt * 32, S1, lane);
        WAIT_VM0();
        __syncthreads();
        if (more) { for (int q = wid; q < 24; q += 8) dma_one(lds, QKD + q * 1024, gn + (q < 8 ? 32768 + q * 1024 : 57344 + (q - 8) * 1024), lane); }
#pragma unroll
        for (int k2 = 0; k2 < 2; ++k2) { const int row = rowA + 32 * k2; float ov[8];
            { const bf16x8 o8 = LV8(OT + (row * 136 + cg * 8) * 2);
#pragma unroll
              for (int k = 0; k < 8; ++k) ov[k] = bf2f((unsigned short)o8[k]); }
            float ss = 0.f;
#pragma unroll
            for (int k = 0; k < 8; ++k) ss += ov[k] * ov[k];
            ss = row_sum16(ss);
            const float rs = rsqrtf(ss * (1.f / 128.f) + 1e-6f); const u32x4 gt = k2 ? gate1 : gate0;
            const unsigned gw[4] = {gt.x, gt.y, gt.z, gt.w}; float rv[8];
#pragma unroll
            for (int k = 0; k < 8; ++k) { const float g = (k & 1) ? bfhi(gw[k >> 1]) : bflo(gw[k >> 1]); rv[k] = ov[k] * rs * anw[k] * siluf_(g); }
            u32x4 w; w.x = pack2(rv[0], rv[1]); w.y = pack2(rv[2], rv[3]); w.z = pack2(rv[4], rv[5]); w.w = pack2(rv[6], rv[7]);
            *(u32x4*)(p->xb + (tok0 + 32 * k2) * DM + h * 128 + cg * 8) = w; }
        uc0 = un0; uc1 = un1;
    }
    if (tid == 0) __hip_atomic_store(p->bar + XCD_BAR_WORDS + 64 * bh, (unsigned)((sst + 1) * CPS + 1), __ATOMIC_RELAXED, __HIP_MEMORY_SCOPE_AGENT);
    if (!dry)
#pragma unroll
    for (int ii = 0; ii < 16; ++ii) { Sg[(kt0 * 32 + crow(ii, hh)) * 128 + vt * 32 + l31] = S0[ii]; Sg[((kt0 + 1) * 32 + crow(ii, hh)) * 128 + vt * 32 + l31] = S1[ii]; }
    __syncthreads();
}

DI void scanB(int tidx, PARG p, LAS unsigned char* lds, int bhp, int sst, bool dry = false) {
    int tid_ = tidx; asm volatile("" : "+v"(tid_)); const int tid = tid_, lane = tid & 63, wid = __builtin_amdgcn_readfirstlane(tid >> 6), hh = lane >> 5, l31 = lane & 31;
    const int b = bhp >> 2, hsel = wid >> 2, h = (bhp & 3) * 2 + hsel, q = wid & 3, tt = q >> 1, vt = q & 1, kt = q >> 1;
    const int SS = hsel * 76800, CT = SS + 9216, YT = SS + 18432, RW = SS + 27648, BN = SS + 60416;
    float* Sg = p->p_bmat + (size_t)(b * 8 + h) * 4096;
    const bf16_t* gb = p->scanB + (size_t)(b * 8 + h) * CPS * B_UNIT;
    const char* gbc = (const char*)gb;
    for (int k = q; k < 16; k += 4) dma_one(lds, RW + k * 1024, gbc + (k < 8 ? k * 1024 : 24576 + (k - 8) * 1024), lane);
    for (int k = q; k < 16; k += 4) dma_one(lds, BN + k * 1024, gbc + 8192 + k * 1024, lane);
    f32x16 S = zero16();
    if (sst > 0) {
#pragma unroll
        for (int ii = 0; ii < 16; ++ii) S[ii] = Sg[(vt * 32 + l31) * 64 + kt * 32 + crow(ii, hh)];
    }
    store_tile_T(lds, SS, 72, kt * 32, vt * 32, S, lane);
    const int t256 = tid & 255, cg = t256 & 7, rowA = t256 >> 3, cB0 = h * 64 + cg * 8;
    float lnw[8], lnb[8], muv[8], mug[8];
#pragma unroll
    for (int k = 0; k < 8; ++k) { lnw[k] = p->ln_w[cB0 + k]; lnb[k] = p->ln_b[cB0 + k]; muv[k] = p->mu[1024 + cB0 + k]; mug[k] = p->mu[1536 + cB0 + k]; }
    const u32x4* ct0 = (const u32x4*)(gbc + 32768 + ((tt * 2 + vt) * 64 + lane) * 32);
    u32x4 cu0 = ct0[0], cu1 = ct0[1], cy0 = ct0[512], cy1 = ct0[513], ck0 = ct0[1024], ck1 = ct0[1025];
    WAIT_VM0();
    __syncthreads();
    for (int nl = 0; nl < CPS; ++nl) {
        const int chunk = sst * CPS + nl, ub = (b * 8 + h) * CPS + nl; const bool more = nl + 1 < CPS;
        const char* gn = gbc + (size_t)(nl + 1) * (B_UNIT * 2);
        const int rw = RW + (nl & 1) * 16384, rwn = RW + ((nl + 1) & 1) * 16384;
        if (tid == 0) __hip_atomic_store(p->bar + XCD_BAR_WORDS + 64 * (32 + bhp), (unsigned)(chunk + 1), __ATOMIC_RELAXED, __HIP_MEMORY_SCOPE_AGENT);
        const float* PTg = p->ptb + (size_t)ub * 64;
        float pt[16];
#pragma unroll
        for (int ii = 0; ii < 16; ++ii) pt[ii] = PTg[kt * 32 + crow(ii, hh)];
        const int tg0 = chunk * 64 + rowA; const size_t row0 = (size_t)b * SEQ + tg0; const bf16_t* pc0 = p->proj + row0 * NPAD + BOFF + cB0; const bf16_t* pc1 = pc0 + (size_t)32 * NPAD;
        const u32x4 z4 = {0u, 0u, 0u, 0u};
        const u32x4 vc0 = *(const u32x4*)(pc0 + 1024), gc0 = *(const u32x4*)(pc0 + 1536), vc1 = *(const u32x4*)(pc1 + 1024), gc1 = *(const u32x4*)(pc1 + 1536);
        const u32x4 vp0 = tg0 > 0 ? *(const u32x4*)(pc0 + 1024 - NPAD) : z4, gp0 = tg0 > 0 ? *(const u32x4*)(pc0 + 1536 - NPAD) : z4;
        const u32x4 vp1 = *(const u32x4*)(pc1 + 1024 - NPAD), gp1 = *(const u32x4*)(pc1 + 1536 - NPAD);
        const float bon0 = p->bonus[row0 * 8 + h], bon1 = p->bonus[(row0 + 32) * 8 + h];
        u32x4 nu0 = cu0, nu1 = cu1, ny0 = cy0, ny1 = cy1, nk0 = ck0, nk1 = ck1;
        if (more) { const u32x4* ctn = (const u32x4*)(gn + 32768 + ((tt * 2 + vt) * 64 + lane) * 32);
            nu0 = ctn[0]; nu1 = ctn[1]; ny0 = ctn[512]; ny1 = ctn[513]; nk0 = ctn[1024]; nk1 = ctn[1025]; }
        MEMBAR();
        if (more) {
            dma_one(lds, rwn + q * 1024, gn + q * 1024, lane); dma_one(lds, rwn + (q + 4) * 1024, gn + (q + 4) * 1024, lane);
            dma_one(lds, rwn + 8192 + q * 1024, gn + 24576 + q * 1024, lane); dma_one(lds, rwn + 8192 + (q + 4) * 1024, gn + 24576 + (q + 4) * 1024, lane); }
        MEMBAR();
        f32x16 aC = expand16(cu0, cu1), aY = expand16(cy0, cy1);
#pragma unroll
        for (int s = 0; s < 4; ++s) { const bf16x8 bS = LV8(SS + ((vt * 32 + l31) * 72 + s * 16 + 8 * hh) * 2);
            const bf16x8 aW = LV8(rw + 8192 + ((tt * 4 + s) * 64 + lane) * 16), aR = LV8(rw + ((tt * 4 + s) * 64 + lane) * 16);
            aC = MFMA32(aW, bS, aC); aY = MFMA32(aR, bS, aY); }
        store_tile_T(lds, CT, 72, tt * 32, vt * 32, aC, lane);
        { const f32x16 kv = expand16(ck0, ck1);
#pragma unroll
          for (int ii = 0; ii < 16; ++ii) S[ii] = pt[ii] * S[ii] + kv[ii]; }
        if (more) WAIT_VM4(); else WAIT_VM0();
        __syncthreads();
#pragma unroll
        for (int s = 0; s < 4; ++s) { const bf16x8 bC = LV8(CT + ((vt * 32 + l31) * 72 + s * 16 + 8 * hh) * 2);
            const bf16x8 aN = LV8(BN + 8192 + ((tt * 4 + s) * 64 + lane) * 16), aB = LV8(BN + ((kt * 4 + s) * 64 + lane) * 16);
            aY = MFMA32(aN, bC, aY); S = MFMA32(aB, bC, S); }
#pragma unroll
        for (int ii = 0; ii < 16; ++ii) LH(YT + ((tt * 32 + crow(ii, hh)) * 72 + vt * 32 + l31) * 2) = f2bf(aY[ii]);
        store_tile_T(lds, SS, 72, kt * 32, vt * 32, S, lane);
        WAIT_VM0();
        __syncthreads();
        if (more) { for (int k = q; k < 16; k += 4) dma_one(lds, BN + k * 1024, gn + 8192 + k * 1024, lane); }
#pragma unroll
        for (int k2 = 0; k2 < 2; ++k2) { const int row = rowA + 32 * k2; float yv[8];
            { const bf16x8 y8 = LV8(YT + (row * 72 + cg * 8) * 2);
#pragma unroll
              for (int k = 0; k < 8; ++k) yv[k] = bf2f((unsigned short)y8[k]); }
            float s1 = 0.f, s2 = 0.f;
#pragma unroll
            for (int k = 0; k < 8; ++k) { s1 += yv[k]; s2 += yv[k] * yv[k]; }
            s1 = row_sum8(s1); s2 = row_sum8(s2);
            const float mean = s1 * (1.f / 64.f); const float var = fmaxf(s2 * (1.f / 64.f) - mean * mean, 0.f); const float rstd = rsqrtf(var + 64e-5f);
            const u32x4 vc = k2 ? vc1 : vc0, vp = k2 ? vp1 : vp0, gc = k2 ? gc1 : gc0, gp = k2 ? gp1 : gp0; const float bon = k2 ? bon1 : bon0;
            const unsigned vcw[4] = {vc.x, vc.y, vc.z, vc.w}, vpw[4] = {vp.x, vp.y, vp.z, vp.w}, gcw[4] = {gc.x, gc.y, gc.z, gc.w}, gpw[4] = {gp.x, gp.y, gp.z, gp.w};
            float ov[8];
#pragma unroll
            for (int k = 0; k < 8; ++k) { const float vcur = (k & 1) ? bfhi(vcw[k >> 1]) : bflo(vcw[k >> 1]), vprv = (k & 1) ? bfhi(vpw[k >> 1]) : bflo(vpw[k >> 1]);
                const float gcur = (k & 1) ? bfhi(gcw[k >> 1]) : bflo(gcw[k >> 1]), gprv = (k & 1) ? bfhi(gpw[k >> 1]) : bflo(gpw[k >> 1]);
                const float vv = vcur + (vprv - vcur) * muv[k], gt = gcur + (gprv - gcur) * mug[k];
                const float gn2 = (yv[k] - mean) * rstd * lnw[k] + lnb[k]; ov[k] = (gn2 + bon * vv) * siluf_(gt); }
            u32x4 w; w.x = pack2(ov[0], ov[1]); w.y = pack2(ov[2], ov[3]); w.z = pack2(ov[4], ov[5]); w.w = pack2(ov[6], ov[7]);
            *(u32x4*)(p->xb + (row0 + 32 * k2) * DM + 512 + cB0) = w; }
        cu0 = nu0; cu1 = nu1; cy0 = ny0; cy1 = ny1; ck0 = nk0; ck1 = nk1;
    }
    if (tid == 0) __hip_atomic_store(p->bar + XCD_BAR_WORDS + 64 * (32 + bhp), (unsigned)((sst + 1) * CPS + 1), __ATOMIC_RELAXED, __HIP_MEMORY_SCOPE_AGENT);
    if (!dry)
#pragma unroll
    for (int ii = 0; ii < 16; ++ii) Sg[(vt * 32 + l31) * 64 + kt * 32 + crow(ii, hh)] = S[ii];
    __syncthreads();
}


DI void scan_helper(int tidx, PARG p, int r, int sst) {
    int tid_ = tidx; asm volatile("" : "+v"(tid_)); const int tid = tid_;
    unsigned* prog = p->bar + XCD_BAR_WORDS + 64 * r;
    for (int nl = 0; nl < CPS; ++nl) {
        if (tid == 0) { const unsigned need = (unsigned)(sst * CPS + nl - 1); unsigned spins = 0;
            while ((int)__hip_atomic_load(prog, __ATOMIC_RELAXED, __HIP_MEMORY_SCOPE_AGENT) < (int)need && ++spins < (1u << 20)) __builtin_amdgcn_s_sleep(4); }
        __syncthreads();
        if (r < 32) { const char* g = (const char*)(p->scanA + ((size_t)r * CPS + nl) * A_UNIT) + tid * 16;
#pragma unroll
            for (int k = 0; k < 9; ++k) { const u32x4 v = *(const u32x4*)(g + k * 8192); asm volatile("" :: "v"(v.x)); }
        } else { const int rb = r - 32, b = rb >> 2, h0 = (rb & 3) * 2;
#pragma unroll
            for (int hs = 0; hs < 2; ++hs) { const char* g = (const char*)(p->scanB + ((size_t)(b * 8 + h0 + hs) * CPS + nl) * B_UNIT) + tid * 16;
#pragma unroll
                for (int k = 0; k < 7; ++k) { const u32x4 v = *(const u32x4*)(g + k * 8192); asm volatile("" :: "v"(v.x)); } }
        }
    }
}

DI void sample_token(int tidx, PARG p, LAS unsigned char* lds, int b) {
    int tid_ = tidx; asm volatile("" : "+v"(tid_)); const int tid = tid_, lane = tid & 63, wid = __builtin_amdgcn_readfirstlane(tid >> 6);
    constexpr int QKV = 0, XBS = 1536 * 4, TWS = 3712 * 4, WDEC = 3776 * 4, ASG = 4288 * 4, KKR = 4800 * 4, KMOD = 5312 * 4, KKS = 5824 * 4, NRM = 6336 * 4, BG = 6344 * 4, BON = 6352 * 4, PART = 6360 * 4;
    const size_t R = NTOK + b; const bf16_t* pr = p->proj + R * NPAD;
#pragma unroll
    for (int m = 0; m < 3; ++m) { const int c = tid + 512 * m; const float* sc = p->state_a_conv + (size_t)b * 3 * 1536 + c; const float s0 = sc[0], s1 = sc[1536], s2 = sc[3072], cur = bf2f(pr[c]);
        const float o = s0 * p->conv_w[c] + s1 * p->conv_w[1536 + c] + s2 * p->conv_w[3072 + c] + cur * p->conv_w[4608 + c];
        LF(QKV + c * 4) = siluf_(o); float* oc = p->s_aconv + (size_t)b * 3 * 1536 + c; oc[0] = s1; oc[1536] = s2; oc[3072] = cur; }
    for (int j = tid; j < BW; j += 512) { const float cur = bf2f(pr[BOFF + j]), prev = p->state_b_shift[(size_t)b * BW + j];
        LF(XBS + j * 4) = cur + (prev - cur) * p->mu[j]; p->s_bshift[(size_t)b * BW + j] = cur; }
    __syncthreads();
    { const int hd = wid & 3, which = wid >> 2; const int o0 = which * 512 + hd * 128 + lane * 2; const float a = LF(QKV + o0 * 4), c = LF(QKV + (o0 + 1) * 4);
      const float ss = wave_sum(a * a + c * c); if (lane == 0) LF(NRM + wid * 4) = rsqrtf(ss + 1e-12f) * (which == 0 ? 0.08838834764831845f : 1.f); }
    if (tid < 4) { LF(BG + tid * 4) = sigmoidf_(bf2f(pr[2048 + tid])); LF(BG + (4 + tid) * 4) = __expf(-__expf(p->a_log[tid]) * softplusf_(bf2f(pr[2052 + tid]) + p->dt_bias[tid])); }
    if (tid < 64) LF(TWS + tid * 4) = tanhf_(LF(XBS + (2048 + tid) * 4));
    __syncthreads();
    { const int cB = tid; float lw = 0.f, la = 0.f;
#pragma unroll 4
      for (int l0 = 0; l0 < 64; l0 += 16) { float wv[16], av[16];
#pragma unroll
          for (int l = 0; l < 16; ++l) { wv[l] = p->w2[(l0 + l) * 512 + cB]; av[l] = p->a2[(l0 + l) * 512 + cB]; }
#pragma unroll
          for (int l = 0; l < 16; ++l) { lw += LF(TWS + (l0 + l) * 4) * wv[l]; la += LF(XBS + (2112 + l0 + l) * 4) * av[l]; } }
      const float a = sigmoidf_(p->a0[cB] + la); const float kr = LF(XBS + (512 + cB) * 4);
      LF(WDEC + cB * 4) = __expf(-0.6065306597126334f * sigmoidf_(p->w0[cB] + lw)); LF(ASG + cB * 4) = a; LF(KKR + cB * 4) = kr * p->k_k[cB]; LF(KMOD + cB * 4) = kr * (1.f + (a - 1.f) * p->k_a[cB]); }
    __syncthreads();
    { const int cB = wid * 64 + lane; const float kv = LF(KKR + cB * 4); const float ss = wave_sum(kv * kv); LF(KKS + cB * 4) = kv * rsqrtf(ss + 1e-12f);
      const float bon = wave_sum(LF(XBS + cB * 4) * LF(KMOD + cB * 4) * p->r_k[cB]); if (lane == 0) LF(BON + wid * 4) = bon; }
    __syncthreads();
    {
        const int hd = tid >> 7, v = tid & 127; const float* S0 = p->state_a_mat + ((size_t)b * 4 + hd) * 16384 + v; float* S1 = p->s_amat + ((size_t)b * 4 + hd) * 16384 + v;
        const float nq = LF(NRM + hd * 4), nk = LF(NRM + (4 + hd) * 4), beta = LF(BG + hd * 4), eg = LF(BG + (4 + hd) * 4);
        float kS = 0.f, qS = 0.f, qk = 0.f;
#pragma unroll 1
        for (int k0 = 0; k0 < 128; k0 += 32) { float sv[32];
#pragma unroll
            for (int k = 0; k < 32; ++k) sv[k] = S0[(k0 + k) * 128];
#pragma unroll
            for (int k = 0; k < 32; ++k) { const float qn = LF(QKV + (hd * 128 + k0 + k) * 4) * nq, kn = LF(QKV + (512 + hd * 128 + k0 + k) * 4) * nk; kS += kn * sv[k]; qS += qn * sv[k]; qk += qn * kn; } }
        const float vval = LF(QKV + (1024 + hd * 128 + v) * 4); const float u = beta * (vval - eg * kS); const float o = eg * qS + qk * u;
#pragma unroll 1
        for (int k0 = 0; k0 < 128; k0 += 32) { float sv[32];
#pragma unroll
            for (int k = 0; k < 32; ++k) sv[k] = S0[(k0 + k) * 128];
#pragma unroll
            for (int k = 0; k < 32; ++k) { const float kn = LF(QKV + (512 + hd * 128 + k0 + k) * 4) * nk; S1[(k0 + k) * 128] = eg * sv[k] + kn * u; } }
        const float ss = wave_sum(o * o); if (lane == 0) LF(PART + wid * 4) = ss;
        __syncthreads();
        const float rs = rsqrtf((LF(PART + (2 * hd) * 4) + LF(PART + (2 * hd + 1) * 4)) * (1.f / 128.f) + 1e-6f);
        const float gate = bf2f(pr[1536 + hd * 128 + v]);
        p->xb[R * DM + hd * 128 + v] = f2bf(o * rs * p->a_norm_w[v] * siluf_(gate));
    }
    {
        const int hd = wid, v = lane, cB = hd * 64 + v; const float* S0 = p->state_b_mat + (((size_t)b * 8 + hd) * 64 + v) * 64; float* S1 = p->s_bmat + (((size_t)b * 8 + hd) * 64 + v) * 64;
        f32x4 s[16]; float sa = 0.f;
#pragma unroll
        for (int i = 0; i < 16; ++i) { s[i] = *(const f32x4*)(S0 + 4 * i);
#pragma unroll
            for (int j = 0; j < 4; ++j) sa -= s[i][j] * LF(KKS + (hd * 64 + 4 * i + j) * 4); }
        const float vv = LF(XBS + (1024 + cB) * 4); float y = 0.f;
#pragma unroll
        for (int i = 0; i < 16; ++i) {
#pragma unroll
            for (int j = 0; j < 4; ++j) { const int k = hd * 64 + 4 * i + j; const float sn = s[i][j] * LF(WDEC + k * 4) + sa * (LF(KKS + k * 4) * LF(ASG + k * 4)) + vv * LF(KMOD + k * 4); s[i][j] = sn; y += sn * LF(XBS + k * 4); }
            *(f32x4*)(S1 + 4 * i) = s[i]; }
        const float mean = wave_sum(y) * (1.f / 64.f); const float d = y - mean; const float var = wave_sum(d * d) * (1.f / 64.f);
        const float gn = d * rsqrtf(var + 64e-5f) * p->ln_w[cB] + p->ln_b[cB];
        p->xb[R * DM + 512 + cB] = f2bf((gn + LF(BON + hd * 4) * vv) * siluf_(LF(XBS + (1536 + cB) * 4)));
    }
    __syncthreads();
}

DI void prompt_tail_states(int tidx, PARG p, int b) {
    int tid_ = tidx; asm volatile("" : "+v"(tid_));
    for (int e = tid_; e < 3 * 1536; e += 512) { const int i = e / 1536, c = e % 1536; p->p_aconv[(size_t)b * 4608 + e] = bf2f(p->proj[(size_t)(b * SEQ + 2045 + i) * NPAD + c]); }
    for (int j = tid_; j < BW; j += 512) p->p_bshift[(size_t)b * BW + j] = bf2f(p->proj[(size_t)(b * SEQ + 2047) * NPAD + BOFF + j]);
}

DI void final_norm(int tidx, PARG p) {
    int tid_ = tidx; asm volatile("" : "+v"(tid_)); const int lane = tid_ & 63, wid = __builtin_amdgcn_readfirstlane(tid_ >> 6);
    const int stride = gridDim.x * 8; f32x4 fw[4];
#pragma unroll
    for (int i = 0; i < 4; ++i) fw[i] = *(const f32x4*)(p->final_norm_w + i * 256 + lane * 4);
    for (int row0 = blockIdx.x * 8 + wid; row0 < MROWS; row0 += 4 * stride) {
        f32x4 v[4][4]; float ssr[4];
#pragma unroll
        for (int r = 0; r < 4; ++r) { const int row = row0 + r * stride; ssr[r] = 0.f;
            if (row < MROWS) { ssr[r] = lane < 16 ? p->rowss[(size_t)row * 16 + lane] : 0.f; const float* yr = p->y + (size_t)row * DM;
#pragma unroll
                for (int i = 0; i < 4; ++i) v[r][i] = *(const f32x4*)(yr + i * 256 + lane * 4); } }
#pragma unroll
        for (int r = 0; r < 4; ++r) { const int row = row0 + r * stride;
            if (row < MROWS) { const float sc = rsqrtf(wave_sum(ssr[r]) * (1.f / 1024.f) + 1e-6f); float* yr = p->y + (size_t)row * DM;
#pragma unroll
                for (int i = 0; i < 4; ++i) { f32x4 o; o[0] = v[r][i][0] * sc * fw[i][0]; o[1] = v[r][i][1] * sc * fw[i][1]; o[2] = v[r][i][2] * sc * fw[i][2]; o[3] = v[r][i][3] * sc * fw[i][3];
                    __builtin_nontemporal_store(o, (f32x4*)(yr + i * 256 + lane * 4)); } } }
    }
}

#ifdef DBL_SYNC
#define GSYNC1() do { XcdBarrier xb2; xb2.bar = OPAQUE(kp)->bar; xb2.x = xb_xcc_id(); xb2.st = xst; xcd_barrier(xb2, wave_idx == 0 && LANEID == 0); } while (0)
#define GSYNC() do { GSYNC1(); GSYNC1(); } while (0)
#else
#define GSYNC() do { XcdBarrier xb2; xb2.bar = OPAQUE(kp)->bar; xb2.x = xb_xcc_id(); xb2.st = xst; xcd_barrier(xb2, wave_idx == 0 && LANEID == 0); } while (0)
#endif
__global__ void __launch_bounds__(512, 2) hymba_step_megakernel(Params pv) {
    extern __shared__ __attribute__((aligned(16))) unsigned char shm[];
    LAS unsigned char* lds = (LAS unsigned char*)shm;
    cg::grid_group grid = cg::this_grid();
    volatile LAS unsigned* xst = (volatile LAS unsigned*)(lds + LDS_BYTES - 16);
    if (threadIdx.x == 0) { xst[0] = 0u; xst[1] = 0u; xst[2] = 0u; xst[3] = 0u; }
    __syncthreads();
    const int G = gridDim.x, wg = blockIdx.x;
    const int wave_idx = __builtin_amdgcn_readfirstlane(threadIdx.x >> 6);
#define LANEID ({ int l_; asm volatile("v_mbcnt_lo_u32_b32 %0, -1, 0\n\tv_mbcnt_hi_u32_b32 %0, -1, %0" : "=v"(l_)); l_; })
#define TIDX (wave_idx * 64 + LANEID)
    PARG kp = (PARG)__builtin_amdgcn_kernarg_segment_ptr();
    if (__builtin_expect(pv.y == nullptr, 1)) { grid.sync(); return; }
    (void)xcd_barrier_post(pv.bar, xst);

    phase0(TIDX, OPAQUE(kp), lds);
#ifdef DBL_G
    __syncthreads(); phase0(TIDX, OPAQUE(kp), lds);
#endif
    GSYNC();
#ifdef DBL_G
    { PARG p = OPAQUE(kp); pg8::Gemm g; g.A = p->xb; g.Bt = p->winT; g.M = MPAD; g.N = NPAD; g.K = DM;
      pg8::StaticOrder S; S.init(MPAD, NPAD, G, wg); EpiProj E; E.O = p->proj; E.ldc = NPAD;
      pg8::gemm_phase<EpiProj, pg8::StaticOrder, false>(lds, g, S, E, nullptr, TIDX); }
    __syncthreads();
#endif
    { PARG p = OPAQUE(kp); pg8::Gemm g; g.A = p->xb; g.Bt = p->winT; g.M = MPAD; g.N = NPAD; g.K = DM;
      pg8::StaticOrder S; S.init(MPAD, NPAD, G, wg); EpiProj E; E.O = p->proj; E.ldc = NPAD;
      pg8::gemm_phase<EpiProj, pg8::StaticOrder, false>(lds, g, S, E, nullptr, TIDX); }
    GSYNC();
#define P2_QUEUE(t) do { \
        _Pragma("unroll 1") for (;;) { \
            LBAR(); \
            if (TIDX == 0) *(volatile LAS unsigned*)(lds + LDS_BYTES - 32) = __hip_atomic_fetch_add(OPAQUE(kp)->bar + XCD_BAR_WORDS + 4096 + 64 * (t), 1u, __ATOMIC_RELAXED, __HIP_MEMORY_SCOPE_AGENT); \
            LBAR(); \
            const int q_ = (int)*(volatile LAS unsigned*)(lds + LDS_BYTES - 32); \
            if (q_ >= 96 * CPS) break; \
            const int nl_ = q_ / 96, r_ = q_ % 96; const bool isA_ = r_ < 32; const int bhB_ = r_ - 32; \
            const int srole_ = isA_ ? r_ : 32 + (bhB_ >> 3) * 4 + ((bhB_ & 7) >> 1); \
            if ((t) > 0) { if (TIDX == 0) { const int need_ = ((t) - 1) * CPS + nl_ + 2; unsigned sp_ = 0; \
                    while ((int)__hip_atomic_load(OPAQUE(kp)->bar + XCD_BAR_WORDS + 64 * srole_, __ATOMIC_RELAXED, __HIP_MEMORY_SCOPE_AGENT) < need_ && ++sp_ < (1u << 22)) __builtin_amdgcn_s_sleep(4); } \
                __syncthreads(); } \
            if (isA_) p2a_unit(TIDX, OPAQUE(kp), lds, r_ >> 2, r_ & 3, (t) * CPS + nl_, r_ * CPS + nl_); \
            else p2b_unit(TIDX, OPAQUE(kp), lds, bhB_ >> 3, bhB_ & 7, (t) * CPS + nl_, bhB_ * CPS + nl_); \
        } } while (0)
    P2_QUEUE(0);
    GSYNC();
#pragma unroll 1
    for (int sst = 0; sst < NSUPER; ++sst) {
        const bool helpers = false;
        const int nscan = 64, nsmp = sst == 0 ? 48 : (sst < 3 ? 40 : 0), tokb = sst == 0 ? 0 : (sst == 1 ? 48 : 88); const int nhelp = helpers ? 64 : 0; const int nroles = nscan + nsmp + nhelp + (sst == 3 ? 4 : 0);
#pragma unroll 1
        for (int role = wg; role < nroles; role += G) {
            if (role < 32) scanA(TIDX, OPAQUE(kp), lds, role, sst);
            else if (role < 64) scanB(TIDX, OPAQUE(kp), lds, role - 32, sst);
            else if (role < nscan + nsmp) { const int sb = tokb + role - 64; sample_token(TIDX, OPAQUE(kp), lds, sb); if (sb < 8) prompt_tail_states(TIDX, OPAQUE(kp), sb); }
            else if (role < nscan + nsmp + nhelp) scan_helper(TIDX, OPAQUE(kp), role - nscan - nsmp, sst);
            else {
                PARG p = OPAQUE(kp); pg8::Gemm g; g.A = p->xb; g.Bt = p->woutT; g.M = MPAD; g.N = DM; g.K = DM;
                OneUnit S1; S1.pm = 64; S1.pn = role - (nscan + nsmp + nhelp); EpiOut E; E.xp = p->x_prompt; E.xs = p->x_sample; E.out = p->y; E.rowss = p->rowss;
                pg8::gemm_phase<EpiOut, OneUnit, false>(lds, g, S1, E, nullptr, TIDX); }
        }
        if (sst + 1 < NSUPER) P2_QUEUE(sst + 1);
        GSYNC();
    }
#ifdef DBL_G
    { PARG p = OPAQUE(kp); pg8::Gemm g; g.A = p->xb; g.Bt = p->woutT; g.M = MPAD; g.N = DM; g.K = DM;
      pg8::StaticOrder S; S.init(NTOK, DM, G, wg); EpiOut E; E.xp = p->x_prompt; E.xs = p->x_sample; E.out = p->y; E.rowss = p->rowss;
      pg8::gemm_phase<EpiOut, pg8::StaticOrder, false>(lds, g, S, E, nullptr, TIDX); }
    __syncthreads();
#endif
    { PARG p = OPAQUE(kp); pg8::Gemm g; g.A = p->xb; g.Bt = p->woutT; g.M = MPAD; g.N = DM; g.K = DM;
      pg8::StaticOrder S; S.init(NTOK, DM, G, wg); EpiOut E; E.xp = p->x_prompt; E.xs = p->x_sample; E.out = p->y; E.rowss = p->rowss;
      pg8::gemm_phase<EpiOut, pg8::StaticOrder, false>(lds, g, S, E, nullptr, TIDX); }
    GSYNC();
    final_norm(TIDX, OPAQUE(kp));
}

extern "C" void kernel_launch(void* const* d_in, const int* in_sizes, int n_in, void* d_out, int out_size, void* d_ws, size_t ws_size, hipStream_t stream) {
    (void)in_sizes; (void)n_in; (void)out_size; (void)ws_size;
    static int grid_blocks = 0;
    if (!grid_blocks) {
        int dev = 0, cus = 0, per_cu = 0;
        hipGetDevice(&dev);
        hipDeviceGetAttribute(&cus, hipDeviceAttributeMultiprocessorCount, dev);
        if (hipFuncSetAttribute((const void*)hymba_step_megakernel, hipFuncAttributeMaxDynamicSharedMemorySize, LDS_BYTES) != hipSuccess) fprintf(stderr, "hipFuncSetAttribute failed\n");
        if (hipOccupancyMaxActiveBlocksPerMultiprocessor(&per_cu, (const void*)hymba_step_megakernel, 512, LDS_BYTES) != hipSuccess || per_cu < 1) per_cu = 1;
        grid_blocks = cus * per_cu; if (grid_blocks > 256) grid_blocks = 256;
    }
    Params p{};
    const float* const* in = (const float* const*)d_in;
    p.x_prompt = in[0]; p.x_sample = in[1]; p.state_a_mat = in[2]; p.state_a_conv = in[3]; p.state_b_mat = in[4]; p.state_b_shift = in[5];
    p.norm_w = in[6]; p.w_in = in[7]; p.conv_w = in[8]; p.a_log = in[9]; p.dt_bias = in[10]; p.a_norm_w = in[11]; p.mu = in[12]; p.w0 = in[13]; p.w2 = in[14];
    p.a0 = in[15]; p.a2 = in[16]; p.k_k = in[17]; p.k_a = in[18]; p.r_k = in[19]; p.ln_w = in[20]; p.ln_b = in[21]; p.w_out = in[22]; p.final_norm_w = in[23];
    float* o = (float*)d_out;
    p.y = o; o += (size_t)MROWS * DM;
    p.p_amat = o; o += 8 * 4 * 128 * 128; p.p_aconv = o; o += 8 * 3 * 1536; p.p_bmat = o; o += 8 * 8 * 64 * 64; p.p_bshift = o; o += 8 * BW;
    p.s_amat = o; o += (size_t)128 * 4 * 128 * 128; p.s_aconv = o; o += 128 * 3 * 1536; p.s_bmat = o; o += (size_t)128 * 8 * 64 * 64; p.s_bshift = o;
    unsigned char* w = (unsigned char*)d_ws; size_t off = 0;
    auto take = [&](size_t bytes) { unsigned char* r = w + off; off += (bytes + 255) & ~(size_t)255; return r; };
    p.xb = (bf16_t*)take((size_t)MPAD * DM * 2); p.winT = (bf16_t*)take((size_t)NPAD * DM * 2); p.woutT = (bf16_t*)take((size_t)DM * DM * 2);
    p.proj = (bf16_t*)take((size_t)MPAD * NPAD * 2);
    p.scanA = (bf16_t*)take((size_t)32 * CPS * A_UNIT * 2); p.scanB = (bf16_t*)take((size_t)64 * CPS * B_UNIT * 2);
    p.glast = (float*)take(32 * CPS * 4); p.ptb = (float*)take((size_t)64 * CPS * 64 * 4); p.bonus = (float*)take((size_t)NTOK * 8 * 4); p.rowss = (float*)take((size_t)MPAD * 16 * 4);
    p.bar = (unsigned*)take((XCD_BAR_WORDS + 4096 + 8 * 64) * 4);
    hipMemsetAsync(p.bar, 0, (XCD_BAR_WORDS + 4096 + 8 * 64) * 4, stream);
    void* args[] = {&p};
    hipError_t e = hipLaunchCooperativeKernel((const void*)hymba_step_megakernel, dim3(grid_blocks), dim3(512), args, LDS_BYTES, stream);
    if (e != hipSuccess) fprintf(stderr, "cooperative launch failed: %s (grid %d)\n", hipGetErrorString(e), grid_blocks);
}
```

```cpp
#include <hip/hip_runtime.h>
#include <hip/hip_cooperative_groups.h>
#include <cstdio>
namespace cg = cooperative_groups;
namespace pg8 {
#define PG8_LAS __attribute__((address_space(3)))
typedef unsigned short bf16_t;
typedef short bf16x8 __attribute__((ext_vector_type(8)));
typedef float f32x4 __attribute__((ext_vector_type(4)));
typedef unsigned u32x4 __attribute__((ext_vector_type(4)));
constexpr int BM = 256, BK = 64, HALF = 128, HTB = HALF * BK * 2  , STAGE_BYTES = 8 * HTB, NXCD = 8, WGM = 8;

__host__ __device__ __forceinline__ int lds_byte(int r, int c) { const int st = (r >> 4) * 2 + (c >> 5), rr = r & 15, cc = c & 31, ob = rr * 64 + cc * 2; return st * 1024 + (ob ^ (((ob >> 9) & 1) << 5)); }
__host__ __device__ __forceinline__ void stage_rc(int b, int& R, int& C) { const int st = b / 1024, sb = b % 1024, swz = sb ^ (((sb >> 9) & 1) << 5); R = (st >> 1) * 16 + swz / 64; C = (st & 1) * 32 + (swz % 64) / 2; }
__host__ __device__ __forceinline__ int perm32(int rho) { const int n = rho >> 4, i = rho & 15; return 8 * (i >> 2) + 4 * n + (i & 3); }

struct Unit { int pm, pn; };
struct Gemm { const bf16_t* A; const bf16_t* Bt; int M, N, K; };

struct StaticOrder {
    int nM, nN, nwg, G, c;
    __host__ __device__ void init(int M, int N, int G_, int c_) { nM = M / BM; nN = N / BM; nwg = nM * nN; G = G_; c = c_; }
    __host__ __device__ bool next(int i, Unit& u) const {
        const long L = (long)i * G + c; if (L >= nwg) return false;
        int wgid = (int)L; { const int q = nwg / NXCD, r = nwg % NXCD, xcd = wgid % NXCD, off = wgid / NXCD; wgid = (xcd < r ? xcd * (q + 1) : r * (q + 1) + (xcd - r) * q) + off; }
        const int nig = WGM * nN, gid = wgid / nig, fm = gid * WGM, gsz = (nM - fm) < WGM ? (nM - fm) : WGM;
        u.pm = fm + ((wgid % nig) % gsz); u.pn = (wgid % nig) / gsz; return true;
    }
    __device__ __forceinline__ void a_ready(const Unit&) const {}
    __device__ __forceinline__ void done(const Unit&) const {}
};

template <class Epi, class Sched, bool STAMP = false>
__device__ __forceinline__ void gemm_phase(PG8_LAS unsigned char* lds, const Gemm g, const Sched& S, const Epi& E, unsigned long long* stamps, int tidx) {
    int tid_ = tidx; asm volatile("" : "+v"(tid_));
    const int tid = tid_, wid = __builtin_amdgcn_readfirstlane(tid >> 6), lane = tid & 63, wr = wid >> 2, wc = wid & 3, fr = lane & 15, fq = lane >> 4;
    const int K = g.K, nt = K / BK;
    int ts_lo = 0, ts_hi = 0, nts = 0; const unsigned long long rt_entry = STAMP ? (unsigned long long)wall_clock64() : 0ull;
#define PG8_STAMP() do { if (STAMP && wid == 0 && nts < 64) { const unsigned long long _c = (unsigned long long)clock64(); \
        ts_lo = (lane == nts) ? (int)(unsigned)_c : ts_lo; ts_hi = (lane == nts) ? (int)(unsigned)(_c >> 32) : ts_hi; ++nts; } } while (0)
    PG8_STAMP();
    unsigned voffA[2], voffB[2];
#pragma unroll
    for (int i = 0; i < 2; ++i) { int R, C; stage_rc(tid * 16 + i * 8192, R, C); const int Rb = Epi::PERM ? ((R & ~31) + perm32(R & 31)) : R;
        voffA[i] = (unsigned)(R * K + C) * 2u; voffB[i] = (unsigned)(Rb * K + C) * 2u; }
    const size_t kstep = (size_t)(BK * 2);
    const size_t hstep = (size_t)HALF * K * 2;
    const size_t tstep = 2 * hstep;
    const unsigned ldsw = (unsigned)wid * 1024u;
    const int aoff = lds_byte(wr * 64 + fr, fq * 8), boff = lds_byte(wc * 32 + fr, fq * 8);
#define PG8_SA(b, h) (((b) * 2 + (h)) * HTB)
#define PG8_SB(b, h) ((4 + (b) * 2 + (h)) * HTB)
#define PG8_STAGE(bufoff, gbase, voff) do { _Pragma("unroll") for (int _i = 0; _i < 2; ++_i) \
        __builtin_amdgcn_global_load_lds((const unsigned*)((const char*)(gbase) + (voff)[_i]), (PG8_LAS unsigned*)(lds + (bufoff) + ldsw + _i * 8192), 16, 0, 0); } while (0)
#define PG8_LDA(dst, b, h) do { _Pragma("unroll") for (int m = 0; m < 4; ++m) _Pragma("unroll") for (int k = 0; k < 2; ++k) dst[m][k] = *(const PG8_LAS bf16x8*)(lds + PG8_SA(b, h) + aoff + m * 2048 + k * 1024); } while (0)
#define PG8_LDB(dst, b, h) do { _Pragma("unroll") for (int n = 0; n < 2; ++n) _Pragma("unroll") for (int k = 0; k < 2; ++k) dst[n][k] = *(const PG8_LAS bf16x8*)(lds + PG8_SB(b, h) + boff + n * 2048 + k * 1024); } while (0)
#define PG8_MMA(ai, bj, At, Bt) do { __builtin_amdgcn_s_setprio(1); _Pragma("unroll") for (int m = 0; m < 4; ++m) _Pragma("unroll") for (int n = 0; n < 2; ++n) _Pragma("unroll") for (int k = 0; k < 2; ++k) \
        acc[ai][bj][m][n] = __builtin_amdgcn_mfma_f32_16x16x32_bf16(Bt[n][k], At[m][k], acc[ai][bj][m][n], 0, 0, 0); __builtin_amdgcn_s_setprio(0); } while (0)
#define PG8_WAIT_V(n) asm volatile("s_waitcnt vmcnt(" #n ")" ::: "memory")
#define PG8_WAIT_L(n) asm volatile("s_waitcnt lgkmcnt(" #n ")" ::: "memory")
#define PG8_BAR __builtin_amdgcn_s_barrier()
#define PG8_SCHED __builtin_amdgcn_sched_barrier(0)
    Unit cur, nxt; int ui = 0;
    if (!S.next(0, cur)) return;
    f32x4 acc[2][2][4][2];
#pragma unroll
    for (int a = 0; a < 2; ++a)
#pragma unroll
        for (int b = 0; b < 2; ++b)
#pragma unroll
            for (int m = 0; m < 4; ++m)
#pragma unroll
                for (int n = 0; n < 2; ++n) acc[a][b][m][n] = (f32x4){0.f, 0.f, 0.f, 0.f};
    bf16x8 At[4][2], B0[2][2], B1[2][2];
    const char* cA = (const char*)g.A + (size_t)cur.pm * tstep; const char* cB = (const char*)g.Bt + (size_t)cur.pn * tstep;
    S.a_ready(cur);
    PG8_STAGE(PG8_SB(0, 0), cB, voffB); PG8_STAGE(PG8_SA(0, 0), cA, voffA); PG8_STAGE(PG8_SB(0, 1), cB + hstep, voffB); PG8_STAGE(PG8_SA(0, 1), cA + hstep, voffA);
    if (wr == 1) PG8_BAR;
    PG8_WAIT_V(4); PG8_BAR;
    PG8_STAGE(PG8_SB(1, 0), cB + kstep, voffB); PG8_STAGE(PG8_SA(1, 0), cA + kstep, voffA); PG8_STAGE(PG8_SB(1, 1), cB + hstep + kstep, voffB);
    PG8_WAIT_V(6); PG8_BAR;
    PG8_STAMP();
    for (;;) {
        const bool has_next = S.next(ui + 1, nxt);
        const char* nA = has_next ? (const char*)g.A + (size_t)nxt.pm * tstep : cA; const char* nB = has_next ? (const char*)g.Bt + (size_t)nxt.pn * tstep : cB;
        for (int t = 0; t < nt; t += 2) {
            const bool last = (t == nt - 2);
            const char* a1 = cA + (size_t)(t + 1) * kstep;
            const char* a2 = last ? nA : cA + (size_t)(t + 2) * kstep; const char* b2 = last ? nB : cB + (size_t)(t + 2) * kstep;
            const char* a3 = a2 + kstep; const char* b3 = b2 + kstep;
            if (last && has_next) S.a_ready(nxt);
            PG8_LDB(B0, 0, 0); PG8_SCHED; PG8_LDA(At, 0, 0); PG8_STAGE(PG8_SA(1, 1), a1 + hstep, voffA);
            PG8_WAIT_L(8); PG8_BAR; PG8_WAIT_L(0); PG8_MMA(0, 0, At, B0); PG8_BAR; PG8_SCHED;
            PG8_LDB(B1, 0, 1); PG8_STAGE(PG8_SB(0, 0), b2, voffB);
            PG8_BAR; PG8_WAIT_L(0); PG8_MMA(0, 1, At, B1); PG8_BAR;
            PG8_LDA(At, 0, 1); PG8_STAGE(PG8_SA(0, 0), a2, voffA);
            PG8_BAR; PG8_WAIT_L(0); PG8_MMA(1, 0, At, B0); PG8_BAR; PG8_SCHED;
            PG8_STAGE(PG8_SB(0, 1), b2 + hstep, voffB);
            PG8_WAIT_V(6); PG8_BAR; PG8_MMA(1, 1, At, B1); PG8_BAR;
            PG8_LDB(B0, 1, 0); PG8_SCHED; PG8_LDA(At, 1, 0); PG8_STAGE(PG8_SA(0, 1), a2 + hstep, voffA);
            PG8_WAIT_L(8); PG8_BAR; PG8_WAIT_L(0); PG8_MMA(0, 0, At, B0); PG8_BAR; PG8_SCHED;
            PG8_LDB(B1, 1, 1); PG8_STAGE(PG8_SB(1, 0), b3, voffB);
            PG8_BAR; PG8_WAIT_L(0); PG8_MMA(0, 1, At, B1); PG8_BAR;
            PG8_LDA(At, 1, 1); PG8_STAGE(PG8_SA(1, 0), a3, voffA);
            PG8_BAR; PG8_WAIT_L(0); PG8_MMA(1, 0, At, B0); PG8_BAR; PG8_SCHED;
            PG8_STAGE(PG8_SB(1, 1), b3 + hstep, voffB);
            PG8_WAIT_V(6); PG8_BAR; PG8_MMA(1, 1, At, B1); PG8_BAR;
        }
        PG8_STAMP();
        if constexpr (!Epi::AFTER_DRAIN) { E(acc, cur, wr, wc, fr, fq); S.done(cur); }
        PG8_STAMP();
        if (!has_next) break;
#pragma unroll
        for (int a = 0; a < 2; ++a)
#pragma unroll
            for (int b = 0; b < 2; ++b)
#pragma unroll
                for (int m = 0; m < 4; ++m)
#pragma unroll
                    for (int n = 0; n < 2; ++n) acc[a][b][m][n] = (f32x4){0.f, 0.f, 0.f, 0.f};
        cur = nxt; cA = nA; cB = nB; ++ui;
    }
    PG8_WAIT_V(0);
    if (wr == 0) PG8_BAR;
    PG8_BAR;
    if constexpr (Epi::AFTER_DRAIN) { E.fused(acc, cur, wr, wc, fr, fq, lds, wid, lane); S.done(cur); }
    PG8_STAMP();
    if (STAMP && wid == 0) { stamps[lane] = lane < nts ? (((unsigned long long)(unsigned)ts_hi << 32) | (unsigned)ts_lo) : 0ull;
        if (lane == 62) stamps[62] = rt_entry; if (lane == 63) stamps[63] = (unsigned long long)wall_clock64(); }
#undef PG8_STAMP
#undef PG8_SA
#undef PG8_SB
#undef PG8_STAGE
#undef PG8_LDA
#undef PG8_LDB
#undef PG8_MMA
#undef PG8_WAIT_V
#undef PG8_WAIT_L
#undef PG8_BAR
#undef PG8_SCHED
}
}

__device__ __forceinline__ unsigned cvt_pk_bf16(float lo, float hi) { unsigned r; asm volatile("v_cvt_pk_bf16_f32 %0, %1, %2" : "=v"(r) : "v"(lo), "v"(hi)); return r; }
#define LAS __attribute__((address_space(3)))

#define XB_TMO      128
#define XB_XCNT(j)  (256  + 64 * (j))
#define XB_XSUB(j)  (1280 + 64 * (j))
#define XB_XGEN(j)  (2304 + 64 * (j))
#define XB_TOP      3328
#define XB_TOPGEN   3392
#define XCD_BAR_WORDS 3456
#define XB_SPIN_CAP (1u << 18)


__device__ __forceinline__ unsigned xb_ld(unsigned* p)              { return __hip_atomic_load(p, __ATOMIC_RELAXED, __HIP_MEMORY_SCOPE_AGENT); }
__device__ __forceinline__ unsigned xb_add(unsigned* p, unsigned v) { return __hip_atomic_fetch_add(p, v, __ATOMIC_RELAXED, __HIP_MEMORY_SCOPE_AGENT); }
__device__ __forceinline__ unsigned xb_xcc_id() { return (unsigned)__builtin_amdgcn_s_getreg((3 << 11) | 20) & 0xFu; }
#define XB_SPIN(cond, bar) do { unsigned _sp = 0; while (cond) { __builtin_amdgcn_s_sleep(1); \
    if ((++_sp & 255u) == 0u) { if (xb_ld(&(bar)[XB_TMO])) break; if (_sp > XB_SPIN_CAP) { atomicAdd(&(bar)[XB_TMO], 1u); break; } } } } while (0)

struct XcdBarrier {
    unsigned* bar; unsigned x;
    volatile LAS unsigned* st;
};

__device__ __forceinline__ XcdBarrier xcd_barrier_post(unsigned* bar, volatile LAS unsigned* st) {
    XcdBarrier b; b.bar = bar; b.x = xb_xcc_id(); b.st = st;
    if (threadIdx.x == 0) (void)xb_add(&bar[XB_XCNT(b.x)], 1u);
    return b;
}
__device__ __forceinline__ void xcd_barrier_complete(unsigned* bar, unsigned x, unsigned& nloc, unsigned& nx) {
    const unsigned G = gridDim.x * gridDim.y * gridDim.z;
    unsigned sum, cnt, mine, sp = 0u;
    for (;;) {
        sum = 0u; cnt = 0u; mine = 0u;
#pragma unroll
        for (unsigned j = 0; j < 16; ++j) { const unsigned c = xb_ld(&bar[XB_XCNT(j)]); sum += c; cnt += (c > 0u) ? 1u : 0u; mine = (j == x) ? c : mine; }
        if (sum == G) break;
        __builtin_amdgcn_s_sleep(1);
        if ((++sp & 255u) == 0u) { if (xb_ld(&bar[XB_TMO])) break; if (sp > XB_SPIN_CAP) { atomicAdd(&bar[XB_TMO], 1u); break; } }
    }
    nloc = mine > 0u ? mine : 1u; nx = cnt > 0u ? cnt : 1u;
}

__device__ __forceinline__ void xcd_barrier(const XcdBarrier& b, bool is_t0) {
    asm volatile("s_waitcnt vmcnt(0)" ::: "memory");
    __syncthreads();
    if (is_t0) {
        unsigned* bar = b.bar;
        __builtin_amdgcn_s_waitcnt(0);
        unsigned nloc = b.st[0], nx = b.st[1];
        if (nloc == 0u) { xcd_barrier_complete(bar, b.x, nloc, nx); b.st[0] = nloc; b.st[1] = nx; }
        const unsigned old = xb_add(&bar[XB_XSUB(b.x)], 1u);
        const unsigned gen = old / nloc;
        if (old + 1u == (gen + 1u) * nloc) {
            __builtin_amdgcn_fence(__ATOMIC_RELEASE, "agent");
            asm volatile("s_waitcnt vmcnt(0)" ::: "memory");
            const unsigned og = xb_add(&bar[XB_TOP], 1u);
            const unsigned tg = og / nx;
            if (og + 1u == (tg + 1u) * nx) xb_add(&bar[XB_TOPGEN], 1u);
            else XB_SPIN(xb_ld(&bar[XB_TOPGEN]) == tg, bar);
            __builtin_amdgcn_fence(__ATOMIC_ACQUIRE, "agent");
            xb_add(&bar[XB_XGEN(b.x)], 1u);
            asm volatile("s_waitcnt vmcnt(0)" ::: "memory");
        } else {
            XB_SPIN(xb_ld(&bar[XB_XGEN(b.x)]) == gen, bar);
            __builtin_amdgcn_fence(__ATOMIC_ACQUIRE, "agent");
            asm volatile("s_waitcnt vmcnt(0)" ::: "memory");
        }
    }
    __syncthreads();
}


using pg8::bf16_t; using pg8::bf16x8; using pg8::f32x4; using pg8::u32x4;
typedef float f32x16 __attribute__((ext_vector_type(16)));
typedef unsigned u32x2 __attribute__((ext_vector_type(2)));
typedef float f32x2 __attribute__((ext_vector_type(2)));
#define LAS __attribute__((address_space(3)))
#define DI __device__ __forceinline__
#define PARG const __attribute__((address_space(4))) Params*
#define OPAQUE(q) ({ PARG q_ = (q); asm volatile("" : "+s"(q_)); q_; })
#define LF(off)  (*(LAS float*)(lds + (off)))
#define LF2(off) (*(LAS f32x2*)(lds + (off)))
#define LF4(off) (*(LAS f32x4*)(lds + (off)))
#define LH(off)  (*(LAS unsigned short*)(lds + (off)))
#define LU1(off) (*(LAS unsigned*)(lds + (off)))
#define LU2(off) (*(LAS u32x2*)(lds + (off)))
#define LV8(off) (*(LAS bf16x8*)(lds + (off)))
#define LBAR() do { asm volatile("s_waitcnt lgkmcnt(0)" ::: "memory"); __builtin_amdgcn_s_barrier(); asm volatile("" ::: "memory"); } while (0)
#define MFMA32(a, b, c) __builtin_amdgcn_mfma_f32_32x32x16_bf16((a), (b), (c), 0, 0, 0)

constexpr int DM = 1024, NTOK = 16384, NSMP = 128, MROWS = 16512, MPAD = 16640, SEQ = 2048;
constexpr int PW = 4232, NPAD = 4352, BOFF = 2176, BW = 2176;
constexpr int NSUPER = 4, CPS = 8;
constexpr int A_UNIT = 36864, B_UNIT = 28672;
constexpr int LDS_BYTES = 163840;

struct Params {
    const float *x_prompt, *x_sample, *state_a_mat, *state_a_conv, *state_b_mat, *state_b_shift;
    const float *norm_w, *w_in, *conv_w, *a_log, *dt_bias, *a_norm_w, *mu, *w0, *w2, *a0, *a2, *k_k, *k_a, *r_k, *ln_w, *ln_b, *w_out, *final_norm_w;
    float *y, *p_amat, *p_aconv, *p_bmat, *p_bshift, *s_amat, *s_aconv, *s_bmat, *s_bshift;
    bf16_t *xb, *winT, *woutT, *proj, *scanA, *scanB;
    float *glast, *ptb, *bonus, *rowss;
    unsigned* bar;
};

typedef __bf16 bf16x2_t __attribute__((ext_vector_type(2)));
DI unsigned pack2(float lo, float hi) { f32x2 v; v.x = lo; v.y = hi; const bf16x2_t b = __builtin_convertvector(v, bf16x2_t); return __builtin_bit_cast(unsigned, b); }
DI unsigned short f2bf(float f) { return (unsigned short)(pack2(f, 0.f) & 0xffffu); }
DI float bf2f(unsigned short b) { return __uint_as_float(((unsigned)b) << 16); }
DI float bflo(unsigned u) { return __uint_as_float(u << 16); }
DI float bfhi(unsigned u) { return __uint_as_float(u & 0xffff0000u); }
#define DPPF(v, ctrl, rmask, bc) __int_as_float(__builtin_amdgcn_update_dpp(0, __float_as_int(v), (ctrl), (rmask), 0xF, (bc)))
DI float row_sum16(float v) {
    v += DPPF(v, 0xB1, 0xF, true); v += DPPF(v, 0x4E, 0xF, true); v += DPPF(v, 0x141, 0xF, true); v += DPPF(v, 0x140, 0xF, true); return v; }
DI float row_sum8(float v) {
    v += DPPF(v, 0xB1, 0xF, true); v += DPPF(v, 0x4E, 0xF, true); v += DPPF(v, 0x141, 0xF, true); return v; }
DI float wave_sum(float v) {
    v = row_sum16(v); v += DPPF(v, 0x142, 0xA, false); v += DPPF(v, 0x143, 0xC, false);
    return __int_as_float(__builtin_amdgcn_readlane(__float_as_int(v), 63)); }
DI int crow(int i, int h) { return (i & 3) + 8 * (i >> 2) + 4 * h; }
DI int idxA(int row, int k, int KS) { return (((row >> 5) * KS + (k >> 4)) * 64 + ((k >> 3) & 1) * 32 + (row & 31)) * 8 + (k & 7); }
DI float sigmoidf_(float x) { return __builtin_amdgcn_rcpf(1.f + __expf(-x)); }
DI float siluf_(float x) { return x * __builtin_amdgcn_rcpf(1.f + __expf(-x)); }
DI float softplusf_(float x) { return x > 20.f ? x : __logf(1.f + __expf(x)); }
DI float tanhf_(float x) { return 1.f - 2.f * __builtin_amdgcn_rcpf(1.f + __expf(2.f * x)); }
DI f32x16 zero16() { f32x16 r;
#pragma unroll
    for (int i = 0; i < 16; ++i) r[i] = 0.f;
    return r; }
DI f32x16 load_ctile(const bf16_t* base, int tile, int lane) {
    const u32x4* q = (const u32x4*)(base + ((size_t)tile * 64 + lane) * 16); const u32x4 a = q[0], b = q[1]; f32x16 r;
    r[0] = bflo(a.x); r[1] = bfhi(a.x); r[2] = bflo(a.y); r[3] = bfhi(a.y); r[4] = bflo(a.z); r[5] = bfhi(a.z); r[6] = bflo(a.w); r[7] = bfhi(a.w);
    r[8] = bflo(b.x); r[9] = bfhi(b.x); r[10] = bflo(b.y); r[11] = bfhi(b.y); r[12] = bflo(b.z); r[13] = bfhi(b.z); r[14] = bflo(b.w); r[15] = bfhi(b.w);
    return r; }
DI void store_ctile(bf16_t* base, int tile, int lane, const f32x16& v) {
    u32x4* q = (u32x4*)(base + ((size_t)tile * 64 + lane) * 16); u32x4 a, b;
    a.x = pack2(v[0], v[1]); a.y = pack2(v[2], v[3]); a.z = pack2(v[4], v[5]); a.w = pack2(v[6], v[7]);
    b.x = pack2(v[8], v[9]); b.y = pack2(v[10], v[11]); b.z = pack2(v[12], v[13]); b.w = pack2(v[14], v[15]);
    q[0] = a; q[1] = b; }
DI void store_tile_T(LAS unsigned char* lds, int img, int ld, int r0, int c0, const f32x16& v, int lane) {
    const int hh = lane >> 5, l31 = lane & 31;
#pragma unroll
    for (int g = 0; g < 4; ++g) { u32x2 w; w.x = pack2(v[4 * g], v[4 * g + 1]); w.y = pack2(v[4 * g + 2], v[4 * g + 3]);
        LU2(img + ((c0 + l31) * ld + r0 + 8 * g + 4 * hh) * 2) = w; } }


template <int I, int SIGN> DI void tri_row(LAS unsigned char* lds, int MOFF, f32x2 (&xv)[32], f32x4 (&an)[16]) {
    constexpr int n4 = (I + 3) >> 2; f32x4 ac[16];
#pragma unroll
    for (int q = 0; q < n4; ++q) ac[q] = an[q];
    if constexpr (I < 63) { constexpr int n4n = (I + 4) >> 2;
#pragma unroll
        for (int q = 0; q < n4n; ++q) an[q] = LF4(MOFF + ((I + 1) * 68 + 4 * q) * 4); }
    f32x2 s01 = {0.f, 0.f}, s23 = {0.f, 0.f};
#pragma unroll
    for (int q = 0; q < n4; ++q) { const f32x2 a01 = {ac[q][0], ac[q][1]}, a23 = {ac[q][2], ac[q][3]};
        s01 = __builtin_elementwise_fma(a01, xv[2 * q], s01); s23 = __builtin_elementwise_fma(a23, xv[2 * q + 1], s23); }
    const f32x2 s2 = s01 + s23; const float s = s2[0] + s2[1];
    xv[I >> 1][I & 1] = SIGN > 0 ? xv[I >> 1][I & 1] + s : xv[I >> 1][I & 1] - s;
    if constexpr (I < 63) tri_row<I + 1, SIGN>(lds, MOFF, xv, an);
}
template <int SIGN> DI void trisolve64(LAS unsigned char* lds, int MOFF, float (&x)[64]) {
    f32x4 an[16]; f32x2 xv[32];
#pragma unroll
    for (int q = 0; q < 32; ++q) { xv[q][0] = x[2 * q]; xv[q][1] = x[2 * q + 1]; }
    an[0] = LF4(MOFF + 68 * 4);
    tri_row<1, SIGN>(lds, MOFF, xv, an);
#pragma unroll
    for (int q = 0; q < 32; ++q) { x[2 * q] = xv[q][0]; x[2 * q + 1] = xv[q][1]; }
}

DI float quad_sum(float v) {
    v += __int_as_float(__builtin_amdgcn_update_dpp(0, __float_as_int(v), 0xB1, 0xF, 0xF, true));
    v += __int_as_float(__builtin_amdgcn_update_dpp(0, __float_as_int(v), 0x4E, 0xF, 0xF, true));
    return v; }
template <int I, int SIGN> DI void tri_row4p(LAS unsigned char* lrow, int s, f32x2 (&xp)[8]) {
    constexpr int n4 = (I + 3) >> 2, nm = (n4 + 3) >> 2;
    f32x2 p01 = {0.f, 0.f}, p23 = {0.f, 0.f};
#pragma unroll
    for (int m = 0; m < nm; ++m) { const f32x4 a = *(LAS f32x4*)(lrow + (I * 68 + 16 * m) * 4); const f32x2 a01 = {a[0], a[1]}, a23 = {a[2], a[3]};
        p01 = __builtin_elementwise_fma(a01, xp[2 * m], p01); p23 = __builtin_elementwise_fma(a23, xp[2 * m + 1], p23); }
    const f32x2 p2 = p01 + p23; const float tot = quad_sum(p2[0] + p2[1]);
    constexpr int own = (I >> 2) & 3, idx = (I >> 4) * 4 + (I & 3);
    const float xi = SIGN > 0 ? xp[idx >> 1][idx & 1] + tot : xp[idx >> 1][idx & 1] - tot;
    xp[idx >> 1][idx & 1] = (s == own) ? xi : xp[idx >> 1][idx & 1];
    if constexpr (I < 63) tri_row4p<I + 1, SIGN>(lrow, s, xp);
}
template <int I, int SIGN> DI void tri_row4(LAS unsigned char* lrow, int s, float (&xo)[16]) {
    static_assert(I == 1, "entry point"); f32x2 xp[8];
#pragma unroll
    for (int q = 0; q < 8; ++q) { xp[q][0] = xo[2 * q]; xp[q][1] = xo[2 * q + 1]; }
    tri_row4p<1, SIGN>(lrow, s, xp);
#pragma unroll
    for (int q = 0; q < 8; ++q) { xo[2 * q] = xp[q][0]; xo[2 * q + 1] = xp[q][1]; }
}
DI float wave_incl_scan(float v, int lane) {
    v += DPPF(v, 0x111, 0xF, true); v += DPPF(v, 0x112, 0xF, true); v += DPPF(v, 0x114, 0xF, true); v += DPPF(v, 0x118, 0xF, true);
    v += DPPF(v, 0x142, 0xA, false); v += DPPF(v, 0x143, 0xC, false);
    return v; }

struct EpiProj {
    static constexpr bool PERM = true, AFTER_DRAIN = false;
    bf16_t* O; int ldc;
    __device__ __forceinline__ void operator()(const f32x4 (&acc)[2][2][4][2], const pg8::Unit& u, int wr, int wc, int fr, int fq) const {
        const int row0 = u.pm * 256 + wr * 64 + fr, col0 = u.pn * 256 + wc * 32 + 8 * fq;
#pragma unroll
        for (int ai = 0; ai < 2; ++ai)
#pragma unroll
            for (int m = 0; m < 4; ++m) { bf16_t* rowp = O + (size_t)(row0 + ai * 128 + m * 16) * ldc + col0;
#pragma unroll
                for (int bj = 0; bj < 2; ++bj) { const f32x4 v0 = acc[ai][bj][m][0], v1 = acc[ai][bj][m][1];
                    u32x4 w; w.x = pack2(v0[0], v0[1]); w.y = pack2(v0[2], v0[3]); w.z = pack2(v1[0], v1[1]); w.w = pack2(v1[2], v1[3]);
                    *(u32x4*)(rowp + bj * 128) = w; } }
    }
};
struct EpiOut {
    static constexpr bool PERM = false, AFTER_DRAIN = false;
    const float* xp; const float* xs; float* out; float* rowss;
    __device__ __forceinline__ void operator()(const f32x4 (&acc)[2][2][4][2], const pg8::Unit& u, int wr, int wc, int fr, int fq) const {
        const int row0 = u.pm * 256 + wr * 64 + fr, col0 = u.pn * 256 + wc * 32 + 4 * fq;
#pragma unroll
        for (int ai = 0; ai < 2; ++ai)
#pragma unroll
            for (int m = 0; m < 4; ++m) { const int r = row0 + ai * 128 + m * 16; const bool valid = r < MROWS; float ss = 0.f;
                if (valid) { const float* xr = r < NTOK ? xp + (size_t)r * DM : xs + (size_t)(r - NTOK) * DM; float* orow = out + (size_t)r * DM;
#pragma unroll
                    for (int bj = 0; bj < 2; ++bj)
#pragma unroll
                        for (int n = 0; n < 2; ++n) { const int c = col0 + bj * 128 + n * 16; const f32x4 hv = *(const f32x4*)(xr + c) + acc[ai][bj][m][n];
                            *(f32x4*)(orow + c) = hv; ss += hv[0] * hv[0] + hv[1] * hv[1] + hv[2] * hv[2] + hv[3] * hv[3]; } }
                ss += __shfl_xor(ss, 16); ss += __shfl_xor(ss, 32);
                if (valid && fq == 0) rowss[(size_t)r * 16 + u.pn * 4 + wc] = ss; }
    }
};

struct OneUnit { int pm, pn;
    __device__ __forceinline__ bool next(int i, pg8::Unit& u) const { if (i > 0) return false; u.pm = pm; u.pn = pn; return true; }
    __device__ __forceinline__ void a_ready(const pg8::Unit&) const {}
    __device__ __forceinline__ void done(const pg8::Unit&) const {}
};

DI void phase0(int tidx, PARG p, LAS unsigned char* lds) {
    int tid_ = tidx; asm volatile("" : "+v"(tid_)); const int tid = tid_, lane = tid & 63, wid = __builtin_amdgcn_readfirstlane(tid >> 6);
    {
        const int stride = gridDim.x * 8; f32x4 nw[4];
#pragma unroll
        for (int i = 0; i < 4; ++i) nw[i] = *(const f32x4*)(p->norm_w + i * 256 + lane * 4);
        for (int row0 = blockIdx.x * 8 + wid; row0 < MPAD; row0 += 4 * stride) {
            f32x4 v[4][4];
#pragma unroll
            for (int r = 0; r < 4; ++r) { const int row = row0 + r * stride;
                if (row < MROWS) { const float* src = row < NTOK ? p->x_prompt + (size_t)row * DM : p->x_sample + (size_t)(row - NTOK) * DM;
#pragma unroll
                    for (int i = 0; i < 4; ++i) v[r][i] = *(const f32x4*)(src + i * 256 + lane * 4);
                } else {
#pragma unroll
                    for (int i = 0; i < 4; ++i) v[r][i] = (f32x4){0.f, 0.f, 0.f, 0.f}; } }
#pragma unroll
            for (int r = 0; r < 4; ++r) { const int row = row0 + r * stride;
                if (row < MPAD) { float ss = 0.f;
#pragma unroll
                    for (int i = 0; i < 4; ++i) ss += v[r][i][0] * v[r][i][0] + v[r][i][1] * v[r][i][1] + v[r][i][2] * v[r][i][2] + v[r][i][3] * v[r][i][3];
                    ss = wave_sum(ss); const float rs = rsqrtf(ss * (1.f / 1024.f) + 1e-6f); bf16_t* dst = p->xb + (size_t)row * DM;
#pragma unroll
                    for (int i = 0; i < 4; ++i) { u32x2 w; w.x = pack2(v[r][i][0] * rs * nw[i][0], v[r][i][1] * rs * nw[i][1]); w.y = pack2(v[r][i][2] * rs * nw[i][2], v[r][i][3] * rs * nw[i][3]);
                        *(u32x2*)(dst + i * 256 + lane * 4) = w; } } }
        }
    }
    for (int t = blockIdx.x; t < 16 * 68 + 16 * 16; t += gridDim.x) {
        const bool isout = t >= 1088; const int tt = isout ? t - 1088 : t; const int nts = isout ? 16 : 68; const int kt = tt / nts, nt = tt % nts;
        const float* W = isout ? p->w_out : p->w_in; const int ldw = isout ? 1024 : PW; bf16_t* dstT = isout ? p->woutT : p->winT;
#pragma unroll
        for (int i = 0; i < 8; ++i) { const int e = tid + 512 * i, kk = e >> 6, nn = e & 63, n = nt * 64 + nn;
            const int sc = isout ? n : (n < 2056 ? n : (n < BOFF ? -1 : n - 120));
            LF((kk * 65 + nn) * 4) = sc >= 0 ? W[(size_t)(kt * 64 + kk) * ldw + sc] : 0.f; }
        __syncthreads();
#pragma unroll
        for (int i = 0; i < 4; ++i) { const int e = tid + 512 * i, nn = e >> 5, kp = e & 31;
            *(unsigned*)(dstT + (size_t)(nt * 64 + nn) * DM + kt * 64 + 2 * kp) = pack2(LF(((2 * kp) * 65 + nn) * 4), LF(((2 * kp + 1) * 65 + nn) * 4)); }
        __syncthreads();
    }
}

DI void lds_copy_out(LAS unsigned char* lds, int lds_off, bf16_t* dst, int bytes, int tid) {
    for (int o = tid * 16; o < bytes; o += 512 * 16) *(u32x4*)((unsigned char*)dst + o) = *(LAS u32x4*)(lds + lds_off + o);
}
DI void p2a_unit(int tidx, PARG p, LAS unsigned char* lds, int b, int h, int chunk, int ua) {
    int tid_ = tidx; asm volatile("" : "+v"(tid_)); const int tid = tid_, lane = tid & 63, wid = __builtin_amdgcn_readfirstlane(tid >> 6), hh = lane >> 5, l31 = lane & 31;
    constexpr int AM = 0, GS = 17408, QB = 18432, KB = 35840, KF = 53248, VF = 86016, QKS = 118784, QGS = 126976, KDS = 143360, WS = KB, US = VF;
    bf16_t* base = p->scanA + (size_t)ua * A_UNIT;
    const int t0 = chunk * 64;
    {
        const int cq = h * 128 + lane * 2;
        float cw[3][4][2];
#pragma unroll
        for (int g3 = 0; g3 < 3; ++g3)
#pragma unroll
            for (int i = 0; i < 4; ++i) { const float* pw = p->conv_w + i * 1536 + g3 * 512 + cq; cw[g3][i][0] = pw[0]; cw[g3][i][1] = pw[1]; }
        unsigned raw[11][3];
#pragma unroll
        for (int r = 0; r < 11; ++r) { const int ts = t0 + wid * 8 - 3 + r;
            if (ts >= 0) { const bf16_t* pr = p->proj + (size_t)(b * SEQ + ts) * NPAD + cq;
#pragma unroll
                for (int g3 = 0; g3 < 3; ++g3) raw[r][g3] = *(const unsigned*)(pr + g3 * 512);
            } else { raw[r][0] = 0u; raw[r][1] = 0u; raw[r][2] = 0u; } }
        float bg = 0.f, gg = 0.f;
        if (lane < 8) { const bf16_t* pr = p->proj + (size_t)(b * SEQ + t0 + wid * 8 + lane) * NPAD; bg = sigmoidf_(bf2f(pr[2048 + h]));
            gg = -__expf(p->a_log[h]) * softplusf_(bf2f(pr[2052 + h]) + p->dt_bias[h]); }
#pragma unroll
        for (int rr = 0; rr < 8; ++rr) {
            const int i = wid * 8 + rr; float o[3][2];
#pragma unroll
            for (int g3 = 0; g3 < 3; ++g3) { o[g3][0] = 0.f; o[g3][1] = 0.f;
#pragma unroll
                for (int tap = 0; tap < 4; ++tap) { const unsigned u = raw[rr + tap][g3]; o[g3][0] += bflo(u) * cw[g3][tap][0]; o[g3][1] += bfhi(u) * cw[g3][tap][1]; } }
            float q0 = siluf_(o[0][0]), q1 = siluf_(o[0][1]), k0 = siluf_(o[1][0]), k1 = siluf_(o[1][1]); const float v0 = siluf_(o[2][0]), v1 = siluf_(o[2][1]);
            const float sq = wave_sum(q0 * q0 + q1 * q1), sk = wave_sum(k0 * k0 + k1 * k1);
            const float rq = rsqrtf(sq + 1e-12f) * 0.08838834764831845f, rk = rsqrtf(sk + 1e-12f);
            q0 *= rq; q1 *= rq; k0 *= rk; k1 *= rk;
            LU1(QB + (i * 136 + lane * 2) * 2) = pack2(q0, q1); LU1(KB + (i * 136 + lane * 2) * 2) = pack2(k0, k1);
            f32x2 kf; kf.x = k0; kf.y = k1; LF2(KF + (i * 128 + lane * 2) * 4) = kf; f32x2 vf; vf.x = v0; vf.y = v1; LF2(VF + (i * 128 + lane * 2) * 4) = vf;
        }
        if (lane < 8) { LF(GS + (wid * 8 + lane) * 4) = gg; LF(GS + 256 + (wid * 8 + lane) * 4) = bg; }
    }
    LBAR();
    if (tid < 64) { const float Gi = wave_incl_scan(LF(GS + tid * 4), lane); const float GLs = __int_as_float(__builtin_amdgcn_readlane(__float_as_int(Gi), 63));
        LF(GS + 512 + tid * 4) = Gi; LF(GS + tid * 4) = __expf(Gi); LF(GS + 768 + tid * 4) = __expf(GLs - Gi); }
    LBAR();
    {
        const int mat = wid >> 2, tile = wid & 3, it = tile >> 1, jt = tile & 1;
        f32x16 acc = zero16();
        const int aoff = (mat ? QB : KB) + ((it * 32 + l31) * 136 + 8 * hh) * 2, boff = KB + ((jt * 32 + l31) * 136 + 8 * hh) * 2;
#pragma unroll
        for (int s = 0; s < 8; ++s) acc = MFMA32(LV8(aoff + s * 32), LV8(boff + s * 32), acc);
        const int j = jt * 32 + l31; const float Gj = LF(GS + 512 + j * 4);
        if (mat == 0) {
#pragma unroll
            for (int ii = 0; ii < 16; ++ii) { const int i = it * 32 + crow(ii, hh); const float Gi = LF(GS + 512 + i * 4); const float dec = __expf(fminf(Gi - Gj, 0.f));
                const float bi = LF(GS + 256 + i * 4); LF(AM + (i * 68 + j) * 4) = (j < i) ? bi * dec * acc[ii] : 0.f; }
        } else {
#pragma unroll
            for (int ii = 0; ii < 16; ++ii) { const int i = it * 32 + crow(ii, hh); const float Gi = LF(GS + 512 + i * 4); const float dec = __expf(fminf(Gi - Gj, 0.f));
                LH(QKS + idxA(i, j, 4) * 2) = f2bf((j <= i) ? dec * acc[ii] : 0.f); }
        }
    }
    LBAR();
    float x[64];
    const int c = tid;
    if (tid < 256) {
        LAS unsigned char* lcol = lds + (c < 128 ? KF + c * 4 : VF + (c - 128) * 4); asm volatile("" : "+v"(lcol));
#pragma unroll
        for (int j = 0; j < 64; ++j) x[j] = *(LAS float*)(lcol + j * 512);
#pragma unroll
        for (int j4 = 0; j4 < 16; ++j4) { const f32x4 bv = LF4(GS + 256 + j4 * 16), gv = LF4(GS + j4 * 16);
#pragma unroll
            for (int k = 0; k < 4; ++k) x[4 * j4 + k] *= (c < 128) ? bv[k] * gv[k] : bv[k]; }
    }
    LBAR();
    if (tid < 256) {
        trisolve64<-1>(lds, AM, x);
        if (c < 128) {
#pragma unroll
            for (int i = 0; i < 64; i += 2) { const unsigned u = pack2(x[i], x[i + 1]); LH(WS + idxA(i, c, 8) * 2) = (unsigned short)u; LH(WS + idxA(i + 1, c, 8) * 2) = (unsigned short)(u >> 16); }
        } else { const int v = c - 128;
#pragma unroll
            for (int m = 0; m < 16; ++m) {
                const int tile = (m >> 3) * 4 + (v >> 5), hh2 = m & 1, ii0 = 4 * ((m & 7) >> 1), ln = (v & 31) + 32 * hh2;
                u32x2 w; w.x = pack2(x[4 * m], x[4 * m + 1]); w.y = pack2(x[4 * m + 2], x[4 * m + 3]);
                LU2(US + ((tile * 64 + ln) * 16 + ii0) * 2) = w; }
        }
    } else {
        const int t2 = tid - 256; const float GL = LF(GS + 512 + 63 * 4);
#pragma unroll
        for (int m = 0; m < 4; ++m) { const int item = t2 + 256 * m, i = item >> 4, g8 = item & 15; const float e = LF(GS + i * 4);
            const bf16x8 q8 = LV8(QB + (i * 136 + g8 * 8) * 2); u32x4 w;
            w.x = pack2(bf2f((unsigned short)q8[0]) * e, bf2f((unsigned short)q8[1]) * e); w.y = pack2(bf2f((unsigned short)q8[2]) * e, bf2f((unsigned short)q8[3]) * e);
            w.z = pack2(bf2f((unsigned short)q8[4]) * e, bf2f((unsigned short)q8[5]) * e); w.w = pack2(bf2f((unsigned short)q8[6]) * e, bf2f((unsigned short)q8[7]) * e);
            *(LAS u32x4*)(lds + QGS + idxA(i, g8 * 8, 8) * 2) = w; }
#pragma unroll
        for (int m = 0; m < 4; ++m) { const int item = t2 + 256 * m, cc = item & 127, g = item >> 7; const f32x4 e0 = LF4(GS + 768 + g * 32), e1 = LF4(GS + 768 + g * 32 + 16);
            float kv[8];
#pragma unroll
            for (int k = 0; k < 8; ++k) kv[k] = LF(KF + ((8 * g + k) * 128 + cc) * 4);
            u32x4 w; w.x = pack2(kv[0] * e0[0], kv[1] * e0[1]); w.y = pack2(kv[2] * e0[2], kv[3] * e0[3]); w.z = pack2(kv[4] * e1[0], kv[5] * e1[1]); w.w = pack2(kv[6] * e1[2], kv[7] * e1[3]);
            *(LAS u32x4*)(lds + KDS + idxA(cc, 8 * g, 4) * 2) = w; }
        if (t2 == 0) p->glast[ua] = __expf(GL);
    }
    LBAR();
    lds_copy_out(lds, WS, base, 16384, tid); lds_copy_out(lds, US, base + 8192, 16384, tid); lds_copy_out(lds, QKS, base + 16384, 40960, tid);
    LBAR();
}

DI void p2b_unit(int tidx, PARG p, LAS unsigned char* lds, int b, int h, int chunk, int ub) {
    int tid_ = tidx; asm volatile("" : "+v"(tid_)); const int tid = tid_, lane = tid & 63, wid = __builtin_amdgcn_readfirstlane(tid >> 6), hh = lane >> 5, l31 = lane & 31;
    constexpr int W2T = 0, A2T = 9216, TW = 18432, AD = 27648, LAs = 36864, LPs = 53248;
    constexpr int MS = 0, MAKB = 17408, NRKB = 26624, MVF = 35840;
    constexpr int AHB = 69632, BHB = 78848, KHB = 88064, RHB = 97280, VT = 106496, KTT = 115712;
    constexpr int RHS = 124928, BTS = 133120, NRBS = 141312, W2S = RHS, U2S = BTS, AHT = 149504, MVT = 35840, TIA = 45056;
    bf16_t* base = p->scanB + (size_t)ub * B_UNIT; bf16_t* Y0g = base + 20480; bf16_t* KVg = base + 24576;
#pragma unroll
    for (int m = 0; m < 8; ++m) { const int e = tid + 512 * m, l = e >> 6, ch = e & 63;
        LH(W2T + (ch * 72 + l) * 2) = f2bf(p->w2[l * 512 + h * 64 + ch]); LH(A2T + (ch * 72 + l) * 2) = f2bf(p->a2[l * 512 + h * 64 + ch]); }
    float r_[8], kr_[8], v_[8];
    {
        const int cols[5] = {h * 64 + lane, 512 + h * 64 + lane, 1024 + h * 64 + lane, 2048 + lane, 2112 + lane};
        float mu5[5]; unsigned short raw[9][5];
#pragma unroll
        for (int q = 0; q < 5; ++q) mu5[q] = p->mu[cols[q]];
#pragma unroll
        for (int r = 0; r < 9; ++r) { const int tg = chunk * 64 + wid * 8 - 1 + r;
            if (tg >= 0) { const bf16_t* pc = p->proj + (size_t)(b * SEQ + tg) * NPAD + BOFF;
#pragma unroll
                for (int q = 0; q < 5; ++q) raw[r][q] = pc[cols[q]];
            } else {
#pragma unroll
                for (int q = 0; q < 5; ++q) raw[r][q] = 0; } }
#pragma unroll
        for (int rr = 0; rr < 8; ++rr) { const int t = wid * 8 + rr; float sh[5];
#pragma unroll
            for (int q = 0; q < 5; ++q) { const float cur = bf2f(raw[rr + 1][q]), prv = bf2f(raw[rr][q]); sh[q] = cur + (prv - cur) * mu5[q]; }
            r_[rr] = sh[0]; kr_[rr] = sh[1]; v_[rr] = sh[2];
            LH(TW + (t * 72 + lane) * 2) = f2bf(tanhf_(sh[3])); LH(AD + (t * 72 + lane) * 2) = f2bf(sh[4]); }
    }
    LBAR();
    {
        const int mat = wid >> 2, tile = wid & 3, it = tile >> 1, jt = tile & 1;
        f32x16 acc = zero16();
        const int aoff = (mat ? AD : TW) + ((it * 32 + l31) * 72 + 8 * hh) * 2, boff = (mat ? A2T : W2T) + ((jt * 32 + l31) * 72 + 8 * hh) * 2;
#pragma unroll
        for (int s = 0; s < 4; ++s) acc = MFMA32(LV8(aoff + s * 32), LV8(boff + s * 32), acc);
        const int ch = jt * 32 + l31; const float bias = mat ? p->a0[h * 64 + ch] : p->w0[h * 64 + ch];
        const float ofac = mat ? 1.f : -0.6065306597126334f; const int obase = mat ? LAs : LPs;
#pragma unroll
        for (int ii = 0; ii < 16; ++ii) { const int t = it * 32 + crow(ii, hh); const float z = bias + acc[ii];
            LF(obase + (t * 64 + ch) * 4) = ofac * sigmoidf_(z); }
    }
    LBAR();
#pragma unroll
    for (int q = 0; q < 8; ++q) { const int ch = wid * 8 + q; LF(LPs + (lane * 64 + ch) * 4) = wave_incl_scan(LF(LPs + (lane * 64 + ch) * 4), lane); }
    LBAR();
    {
        const int ch = lane; const float kkw = p->k_k[h * 64 + ch], kaw = p->k_a[h * 64 + ch], rkw = p->r_k[h * 64 + ch]; const float lpT = LF(LPs + (63 * 64 + ch) * 4); const float PT = __expf(lpT); float Pprev = 1.f;
#pragma unroll
        for (int rp = 0; rp < 4; ++rp) {
            const int t = wid * 8 + 2 * rp;
            f32x2 a, lp, r, kr, vv; a[0] = LF(LAs + (t * 64 + ch) * 4); a[1] = LF(LAs + ((t + 1) * 64 + ch) * 4); lp[0] = LF(LPs + (t * 64 + ch) * 4); lp[1] = LF(LPs + ((t + 1) * 64 + ch) * 4);
            r[0] = r_[2 * rp]; r[1] = r_[2 * rp + 1]; kr[0] = kr_[2 * rp]; kr[1] = kr_[2 * rp + 1]; vv[0] = v_[2 * rp]; vv[1] = v_[2 * rp + 1];
            const f32x2 kkv = kr * kkw, sq = kkv * kkv; f32x2 rs; rs[0] = rsqrtf(wave_sum(sq[0]) + 1e-12f); rs[1] = rsqrtf(wave_sum(sq[1]) + 1e-12f);
            const f32x2 kk = kkv * rs, kmod = kr * ((a - 1.f) * kaw + 1.f), bw = r * kmod * rkw;
            const float bon0 = wave_sum(bw[0]), bon1 = wave_sum(bw[1]);
            if (lane == 0) { float* bp = p->bonus + (size_t)(b * SEQ + chunk * 64 + t) * 8 + h; bp[0] = bon0; bp[8] = bon1; }
            f32x2 P, Pi; P[0] = __expf(lp[0]); P[1] = __expf(lp[1]); Pi[0] = __builtin_amdgcn_rcpf(P[0]); Pi[1] = __builtin_amdgcn_rcpf(P[1]);
            f32x2 Pp; Pp[0] = rp == 0 ? __expf(t > 0 ? LF(LPs + ((t - 1) * 64 + ch) * 4) : 0.f) : Pprev; Pp[1] = P[0]; Pprev = P[1];
            const f32x2 Pt = Pi * PT, ka = kk * a, Ah = -(kk * Pp), Bh = ka * Pi, Kh = kmod * Pi, Rh = r * P, Bt = ka * Pt, Kt = kmod * Pt;
            const unsigned uA = pack2(Ah[0], Ah[1]), uB = pack2(Bh[0], Bh[1]), uK = pack2(Kh[0], Kh[1]), uR = pack2(Rh[0], Rh[1]);
            LH(AHB + (t * 72 + ch) * 2) = (unsigned short)uA; LH(AHB + ((t + 1) * 72 + ch) * 2) = (unsigned short)(uA >> 16);
            LH(BHB + (t * 72 + ch) * 2) = (unsigned short)uB; LH(BHB + ((t + 1) * 72 + ch) * 2) = (unsigned short)(uB >> 16);
            LH(KHB + (t * 72 + ch) * 2) = (unsigned short)uK; LH(KHB + ((t + 1) * 72 + ch) * 2) = (unsigned short)(uK >> 16);
            LH(RHB + (t * 72 + ch) * 2) = (unsigned short)uR; LH(RHB + ((t + 1) * 72 + ch) * 2) = (unsigned short)(uR >> 16);
            LH(RHS + idxA(t, ch, 4) * 2) = (unsigned short)uR; LH(RHS + idxA(t + 1, ch, 4) * 2) = (unsigned short)(uR >> 16);
            LU1(VT + (ch * 72 + t) * 2) = pack2(vv[0], vv[1]); LU1(KTT + (ch * 72 + t) * 2) = pack2(Kt[0], Kt[1]); LU1(AHT + (ch * 72 + t) * 2) = uA;
            LU1(BTS + idxA(ch, t, 4) * 2) = pack2(Bt[0], Bt[1]);
        }
        if (wid == 7) p->ptb[(size_t)ub * 64 + ch] = PT;
    }
    LBAR();
#pragma unroll
    for (int q = 0; q < 2; ++q) {
        const int tileid = 2 * wid + q, mat = tileid >> 2, tl = tileid & 3, it = tl >> 1, jt = tl & 1;
        f32x16 acc = zero16();
        const int aoff = ((mat >= 2) ? RHB : AHB) + ((it * 32 + l31) * 72 + 8 * hh) * 2, boff = ((mat & 1) ? KHB : BHB) + ((jt * 32 + l31) * 72 + 8 * hh) * 2;
#pragma unroll
        for (int s = 0; s < 4; ++s) acc = MFMA32(LV8(aoff + s * 32), LV8(boff + s * 32), acc);
        const int j = jt * 32 + l31;
        if (mat == 0) {
#pragma unroll
            for (int ii = 0; ii < 16; ++ii) { const int i = it * 32 + crow(ii, hh); LF(MS + (i * 68 + j) * 4) = (j < i) ? acc[ii] : 0.f; }
        } else if (mat == 1) {
#pragma unroll
            for (int ii = 0; ii < 16; ++ii) { const int i = it * 32 + crow(ii, hh); LH(MAKB + (i * 72 + j) * 2) = f2bf((j < i) ? acc[ii] : 0.f); }
        } else if (mat == 2) {
#pragma unroll
            for (int ii = 0; ii < 16; ++ii) { const int i = it * 32 + crow(ii, hh); LH(NRBS + idxA(i, j, 4) * 2) = f2bf((j <= i) ? acc[ii] : 0.f); }
        } else {
#pragma unroll
            for (int ii = 0; ii < 16; ++ii) { const int i = it * 32 + crow(ii, hh); LH(NRKB + (i * 72 + j) * 2) = f2bf((j <= i) ? acc[ii] : 0.f); }
        }
    }
    LBAR();
    lds_copy_out(lds, RHS, base, 24576, tid);
    {
        const int mat = wid >> 2, tl = wid & 3, it = tl >> 1, jt = tl & 1;
        f32x16 acc = zero16();
        const int aoff = (mat ? NRKB : MAKB) + ((it * 32 + l31) * 72 + 8 * hh) * 2, boff = VT + ((jt * 32 + l31) * 72 + 8 * hh) * 2;
#pragma unroll
        for (int s = 0; s < 4; ++s) acc = MFMA32(LV8(aoff + s * 32), LV8(boff + s * 32), acc);
        if (mat == 0) store_tile_T(lds, MVT, 72, it * 32, jt * 32, acc, lane);
        else store_ctile(Y0g, it * 2 + jt, lane, acc);
        if (wid < 4) { f32x16 a2 = zero16(); const int ao2 = KTT + ((it * 32 + l31) * 72 + 8 * hh) * 2;
#pragma unroll
            for (int s = 0; s < 4; ++s) a2 = MFMA32(LV8(ao2 + s * 32), LV8(boff + s * 32), a2);
            store_ctile(KVg, it * 2 + jt, lane, a2); }
    }
    LBAR();
    if (tid < 256) {
        const int c = tid >> 2, s = tid & 3; float xo[16];
#pragma unroll
        for (int k = 0; k < 16; ++k) xo[k] = (16 * (k >> 2) + 4 * s + (k & 3) == c) ? 1.f : 0.f;
        LAS unsigned char* lrow = lds + MS + 16 * s; asm volatile("" : "+v"(lrow));
        tri_row4<1, 1>(lrow, s, xo);
#pragma unroll
        for (int k = 0; k < 16; k += 2) { const unsigned u = pack2(xo[k], xo[k + 1]); const int j0 = 16 * (k >> 2) + 4 * s + (k & 3);
            LH(TIA + (j0 * 72 + c) * 2) = (unsigned short)u; LH(TIA + ((j0 + 1) * 72 + c) * 2) = (unsigned short)(u >> 16); }
    }
    LBAR();
    {
        const int mat = wid >> 2, tl = wid & 3, it = tl >> 1, jt = tl & 1;
        f32x16 acc = zero16();
        const int aoff = TIA + ((it * 32 + l31) * 72 + 8 * hh) * 2, boff = (mat ? MVT : AHT) + ((jt * 32 + l31) * 72 + 8 * hh) * 2;
#pragma unroll
        for (int s = 0; s < 4; ++s) acc = MFMA32(LV8(aoff + s * 32), LV8(boff + s * 32), acc);
        if (mat == 0) {
#pragma unroll
            for (int ii = 0; ii < 16; ++ii) LH(W2S + idxA(it * 32 + crow(ii, hh), jt * 32 + l31, 4) * 2) = f2bf(acc[ii]);
        } else { u32x4 a, b2;
            a.x = pack2(acc[0], acc[1]); a.y = pack2(acc[2], acc[3]); a.z = pack2(acc[4], acc[5]); a.w = pack2(acc[6], acc[7]);
            b2.x = pack2(acc[8], acc[9]); b2.y = pack2(acc[10], acc[11]); b2.z = pack2(acc[12], acc[13]); b2.w = pack2(acc[14], acc[15]);
            *(LAS u32x4*)(lds + U2S + ((it * 2 + jt) * 64 + lane) * 32) = a; *(LAS u32x4*)(lds + U2S + ((it * 2 + jt) * 64 + lane) * 32 + 16) = b2; }
    }
    LBAR();
    lds_copy_out(lds, W2S, base + 12288, 16384, tid);
    LBAR();
}

DI void dma_pieces(LAS unsigned char* lds, int lds_off, const bf16_t* g, int first, int n, int w, int nw, int lane) {
    for (int q = first + w; q < first + n; q += nw)
        __builtin_amdgcn_global_load_lds((const unsigned*)((const char*)g + q * 1024 + lane * 16), (LAS unsigned*)(lds + lds_off + q * 1024), 16, 0, 0);
}
DI void dma_one(LAS unsigned char* lds, int lds_byte, const void* gbyte, int lane) {
    __builtin_amdgcn_global_load_lds((const unsigned*)((const char*)gbyte + lane * 16), (LAS unsigned*)(lds + lds_byte), 16, 0, 0);
}
DI f32x16 expand16(const u32x4& a, const u32x4& b) { f32x16 r;
    r[0] = bflo(a.x); r[1] = bfhi(a.x); r[2] = bflo(a.y); r[3] = bfhi(a.y); r[4] = bflo(a.z); r[5] = bfhi(a.z); r[6] = bflo(a.w); r[7] = bfhi(a.w);
    r[8] = bflo(b.x); r[9] = bfhi(b.x); r[10] = bflo(b.y); r[11] = bfhi(b.y); r[12] = bflo(b.z); r[13] = bfhi(b.z); r[14] = bflo(b.w); r[15] = bfhi(b.w);
    return r; }
#define WAIT_VM0() asm volatile("s_waitcnt vmcnt(0)" ::: "memory")
#define WAIT_VM4() asm volatile("s_waitcnt vmcnt(4)" ::: "memory")
#define MEMBAR() asm volatile("" ::: "memory")

DI void scanA(int tidx, PARG p, LAS unsigned char* lds, int bh, int sst, bool dry = false) {
    int tid_ = tidx; asm volatile("" : "+v"(tid_)); const int tid = tid_, lane = tid & 63, wid = __builtin_amdgcn_readfirstlane(tid >> 6), hh = lane >> 5, l31 = lane & 31;
    const int b = bh >> 2, h = bh & 3; const int vt = wid & 3, ct = wid >> 2, kt0 = 2 * (wid >> 2);
    constexpr int ST = 0, UT = 34816, OT = 53248, WQ = 70656, QKD = 136192;
    float* Sg = p->p_amat + (size_t)bh * 16384;
    const bf16_t* gb = p->scanA + (size_t)bh * CPS * A_UNIT;
    const char* gbc = (const char*)gb;
    dma_pieces(lds, WQ, gb, 0, 16, wid, 8, lane);
    for (int q = wid; q < 16; q += 8) dma_one(lds, WQ + 16384 + q * 1024, gbc + 40960 + q * 1024, lane);
    for (int q = wid; q < 24; q += 8) dma_one(lds, QKD + q * 1024, gbc + (q < 8 ? 32768 + q * 1024 : 57344 + (q - 8) * 1024), lane);
    const u32x4* ug = (const u32x4*)(gbc + 16384 + ((ct * 4 + vt) * 64 + lane) * 32);
    u32x4 uc0 = ug[0], uc1 = ug[1];
    f32x16 S0 = zero16(), S1 = zero16();
    if (sst > 0) {
#pragma unroll
        for (int ii = 0; ii < 16; ++ii) { S0[ii] = Sg[(kt0 * 32 + crow(ii, hh)) * 128 + vt * 32 + l31]; S1[ii] = Sg[((kt0 + 1) * 32 + crow(ii, hh)) * 128 + vt * 32 + l31]; }
    }
    store_tile_T(lds, ST, 136, kt0 * 32, vt * 32, S0, lane); store_tile_T(lds, ST, 136, kt0 * 32 + 32, vt * 32, S1, lane);
    const int cg = tid & 15, rowA = tid >> 4;
    float anw[8];
#pragma unroll
    for (int k = 0; k < 8; ++k) anw[k] = p->a_norm_w[cg * 8 + k];
    WAIT_VM0();
    __syncthreads();
    for (int nl = 0; nl < CPS; ++nl) {
        const int chunk = sst * CPS + nl, ua = bh * CPS + nl; const bool more = nl + 1 < CPS;
        const char* gn = gbc + (size_t)(nl + 1) * (A_UNIT * 2);
        const int wq = WQ + (nl & 1) * 32768, wqn = WQ + ((nl + 1) & 1) * 32768;
        if (tid == 0) __hip_atomic_store(p->bar + XCD_BAR_WORDS + 64 * bh, (unsigned)(chunk + 1), __ATOMIC_RELAXED, __HIP_MEMORY_SCOPE_AGENT);
        const float gl = p->glast[ua];
        const size_t tok0 = (size_t)b * SEQ + chunk * 64 + rowA;
        const u32x4 gate0 = *(const u32x4*)(p->proj + tok0 * NPAD + 1536 + h * 128 + cg * 8), gate1 = *(const u32x4*)(p->proj + (tok0 + 32) * NPAD + 1536 + h * 128 + cg * 8);
        u32x4 un0 = uc0, un1 = uc1;
        if (more) { const u32x4* un = (const u32x4*)(gn + 16384 + ((ct * 4 + vt) * 64 + lane) * 32); un0 = un[0]; un1 = un[1]; }
        MEMBAR();
        if (more) {
            dma_one(lds, wqn + wid * 1024, gn + wid * 1024, lane); dma_one(lds, wqn + (wid + 8) * 1024, gn + (wid + 8) * 1024, lane);
            dma_one(lds, wqn + 16384 + wid * 1024, gn + 40960 + wid * 1024, lane); dma_one(lds, wqn + 16384 + (wid + 8) * 1024, gn + 40960 + (wid + 8) * 1024, lane); }
        MEMBAR();
        f32x16 au = zero16(), ao = zero16();
#pragma unroll
        for (int s = 0; s < 8; ++s) { const bf16x8 bS = LV8(ST + ((vt * 32 + l31) * 136 + s * 16 + 8 * hh) * 2);
            const bf16x8 aW = LV8(wq + ((ct * 8 + s) * 64 + lane) * 16), aQ = LV8(wq + 16384 + ((ct * 8 + s) * 64 + lane) * 16);
            au = MFMA32(aW, bS, au); ao = MFMA32(aQ, bS, ao); }
        { const f32x16 uc = expand16(uc0, uc1);
#pragma unroll
          for (int ii = 0; ii < 16; ++ii) au[ii] = uc[ii] - au[ii]; }
        store_tile_T(lds, UT, 72, ct * 32, vt * 32, au, lane);
        if (more) WAIT_VM4(); else WAIT_VM0();
        __syncthreads();
#pragma unroll
        for (int ii = 0; ii < 16; ++ii) { S0[ii] *= gl; S1[ii] *= gl; }
#pragma unroll
        for (int s = 0; s < 4; ++s) { const bf16x8 bU = LV8(UT + ((vt * 32 + l31) * 72 + s * 16 + 8 * hh) * 2);
            const bf16x8 aQK = LV8(QKD + ((ct * 4 + s) * 64 + lane) * 16);
            const bf16x8 aK0 = LV8(QKD + 8192 + ((kt0 * 4 + s) * 64 + lane) * 16), aK1 = LV8(QKD + 8192 + (((kt0 + 1) * 4 + s) * 64 + lane) * 16);
            ao = MFMA32(aQK, bU, ao); S0 = MFMA32(aK0, bU, S0); S1 = MFMA32(aK1, bU, S1); }
#pragma unroll
        for (int ii = 0; ii < 16; ++ii) LH(OT + ((ct * 32 + crow(ii, hh)) * 136 + vt * 32 + l31) * 2) = f2bf(ao[ii]);
        store_tile_T(lds, ST, 136, kt0 * 32, vt * 32, S0, lane); store_tile_T(lds, ST, 136, kt0 * 32 + 32, vt * 32, S1, lane);
        WAIT_VM0();
        __syncthreads();
        if (more) { for (int q = wid; q < 24; q += 8) dma_one(lds, QKD + q * 1024, gn + (q < 8 ? 32768 + q * 1024 : 57344 + (q - 8) * 1024), lane); }
#pragma unroll
        for (int k2 = 0; k2 < 2; ++k2) { const int row = rowA + 32 * k2; float ov[8];
            { const bf16x8 o8 = LV8(OT + (row * 136 + cg * 8) * 2);
#pragma unroll
              for (int k = 0; k < 8; ++k) ov[k] = bf2f((unsigned short)o8[k]); }
            float ss = 0.f;
#pragma unroll
            for (int k = 0; k < 8; ++k) ss += ov[k] * ov[k];
            ss = row_sum16(ss);
            const float rs = rsqrtf(ss * (1.f / 128.f) + 1e-6f); const u32x4 gt = k2 ? gate1 : gate0;
            const unsigned gw[4] = {gt.x, gt.y, gt.z, gt.w}; float rv[8];
#pragma unroll
            for (int k = 0; k < 8; ++k) { const float g = (k & 1) ? bfhi(gw[k >> 1]) : bflo(gw[k >> 1]); rv[k] = ov[k] * rs * anw[k] * siluf_(g); }
            u32x4 w; w.x = pack2(rv[0], rv[1]); w.y = pack2(rv[2], rv[3]); w.z = pack2(rv[4], rv[5]); w.w = pack2(rv[6], rv[7]);
            *(u32x4*)(p->xb + (tok0 + 32 * k2) * DM + h * 128 + cg * 8) = w; }
        uc0 = un0; uc1 = un1;
    }
    if (tid == 0) __hip_atomic_store(p->bar + XCD_BAR_WORDS + 64 * bh, (unsigned)((sst + 1) * CPS + 1), __ATOMIC_RELAXED, __HIP_MEMORY_SCOPE_AGENT);
    if (!dry)
#pragma unroll
    for (int ii = 0; ii < 16; ++ii) { Sg[(kt0 * 32 + crow(ii, hh)) * 128 + vt * 32 + l31] = S0[ii]; Sg[((kt0 + 1) * 32 + crow(ii, hh)) * 128 + vt * 32 + l31] = S1[ii]; }
    __syncthreads();
}

DI void scanB(int tidx, PARG p, LAS unsigned char* lds, int bhp, int sst, bool dry = false) {
    int tid_ = tidx; asm volatile("" : "+v"(tid_)); const int tid = tid_, lane = tid & 63, wid = __builtin_amdgcn_readfirstlane(tid >> 6), hh = lane >> 5, l31 = lane & 31;
    const int b = bhp >> 2, hsel = wid >> 2, h = (bhp & 3) * 2 + hsel, q = wid & 3, tt = q >> 1, vt = q & 1, kt = q >> 1;
    const int SS = hsel * 76800, CT = SS + 9216, YT = SS + 18432, RW = SS + 27648, BN = SS + 60416;
    float* Sg = p->p_bmat + (size_t)(b * 8 + h) * 4096;
    const bf16_t* gb = p->scanB + (size_t)(b * 8 + h) * CPS * B_UNIT;
    const char* gbc = (const char*)gb;
    for (int k = q; k < 16; k += 4) dma_one(lds, RW + k * 1024, gbc + (k < 8 ? k * 1024 : 24576 + (k - 8) * 1024), lane);
    for (int k = q; k < 16; k += 4) dma_one(lds, BN + k * 1024, gbc + 8192 + k * 1024, lane);
    f32x16 S = zero16();
    if (sst > 0) {
#pragma unroll
        for (int ii = 0; ii < 16; ++ii) S[ii] = Sg[(vt * 32 + l31) * 64 + kt * 32 + crow(ii, hh)];
    }
    store_tile_T(lds, SS, 72, kt * 32, vt * 32, S, lane);
    const int t256 = tid & 255, cg = t256 & 7, rowA = t256 >> 3, cB0 = h * 64 + cg * 8;
    float lnw[8], lnb[8], muv[8], mug[8];
#pragma unroll
    for (int k = 0; k < 8; ++k) { lnw[k] = p->ln_w[cB0 + k]; lnb[k] = p->ln_b[cB0 + k]; muv[k] = p->mu[1024 + cB0 + k]; mug[k] = p->mu[1536 + cB0 + k]; }
    const u32x4* ct0 = (const u32x4*)(gbc + 32768 + ((tt * 2 + vt) * 64 + lane) * 32);
    u32x4 cu0 = ct0[0], cu1 = ct0[1], cy0 = ct0[512], cy1 = ct0[513], ck0 = ct0[1024], ck1 = ct0[1025];
    WAIT_VM0();
    __syncthreads();
    for (int nl = 0; nl < CPS; ++nl) {
        const int chunk = sst * CPS + nl, ub = (b * 8 + h) * CPS + nl; const bool more = nl + 1 < CPS;
        const char* gn = gbc + (size_t)(nl + 1) * (B_UNIT * 2);
        const int rw = RW + (nl & 1) * 16384, rwn = RW + ((nl + 1) & 1) * 16384;
        if (tid == 0) __hip_atomic_store(p->bar + XCD_BAR_WORDS + 64 * (32 + bhp), (unsigned)(chunk + 1), __ATOMIC_RELAXED, __HIP_MEMORY_SCOPE_AGENT);
        const float* PTg = p->ptb + (size_t)ub * 64;
        float pt[16];
#pragma unroll
        for (int ii = 0; ii < 16; ++ii) pt[ii] = PTg[kt * 32 + crow(ii, hh)];
        const int tg0 = chunk * 64 + rowA; const size_t row0 = (size_t)b * SEQ + tg0; const bf16_t* pc0 = p->proj + row0 * NPAD + BOFF + cB0; const bf16_t* pc1 = pc0 + (size_t)32 * NPAD;
        const u32x4 z4 = {0u, 0u, 0u, 0u};
        const u32x4 vc0 = *(const u32x4*)(pc0 + 1024), gc0 = *(const u32x4*)(pc0 + 1536), vc1 = *(const u32x4*)(pc1 + 1024), gc1 = *(const u32x4*)(pc1 + 1536);
        const u32x4 vp0 = tg0 > 0 ? *(const u32x4*)(pc0 + 1024 - NPAD) : z4, gp0 = tg0 > 0 ? *(const u32x4*)(pc0 + 1536 - NPAD) : z4;
        const u32x4 vp1 = *(const u32x4*)(pc1 + 1024 - NPAD), gp1 = *(const u32x4*)(pc1 + 1536 - NPAD);
        const float bon0 = p->bonus[row0 * 8 + h], bon1 = p->bonus[(row0 + 32) * 8 + h];
        u32x4 nu0 = cu0, nu1 = cu1, ny0 = cy0, ny1 = cy1, nk0 = ck0, nk1 = ck1;
        if (more) { const u32x4* ctn = (const u32x4*)(gn + 32768 + ((tt * 2 + vt) * 64 + lane) * 32);
            nu0 = ctn[0]; nu1 = ctn[1]; ny0 = ctn[512]; ny1 = ctn[513]; nk0 = ctn[1024]; nk1 = ctn[1025]; }
        MEMBAR();
        if (more) {
            dma_one(lds, rwn + q * 1024, gn + q * 1024, lane); dma_one(lds, rwn + (q + 4) * 1024, gn + (q + 4) * 1024, lane);
            dma_one(lds, rwn + 8192 + q * 1024, gn + 24576 + q * 1024, lane); dma_one(lds, rwn + 8192 + (q + 4) * 1024, gn + 24576 + (q + 4) * 1024, lane); }
        MEMBAR();
        f32x16 aC = expand16(cu0, cu1), aY = expand16(cy0, cy1);
#pragma unroll
        for (int s = 0; s < 4; ++s) { const bf16x8 bS = LV8(SS + ((vt * 32 + l31) * 72 + s * 16 + 8 * hh) * 2);
            const bf16x8 aW = LV8(rw + 8192 + ((tt * 4 + s) * 64 + lane) * 16), aR = LV8(rw + ((tt * 4 + s) * 64 + lane) * 16);
            aC = MFMA32(aW, bS, aC); aY = MFMA32(aR, bS, aY); }
        store_tile_T(lds, CT, 72, tt * 32, vt * 32, aC, lane);
        { const f32x16 kv = expand16(ck0, ck1);
#pragma unroll
          for (int ii = 0; ii < 16; ++ii) S[ii] = pt[ii] * S[ii] + kv[ii]; }
        if (more) WAIT_VM4(); else WAIT_VM0();
        __syncthreads();
#pragma unroll
        for (int s = 0; s < 4; ++s) { const bf16x8 bC = LV8(CT + ((vt * 32 + l31) * 72 + s * 16 + 8 * hh) * 2);
            const bf16x8 aN = LV8(BN + 8192 + ((tt * 4 + s) * 64 + lane) * 16), aB = LV8(BN + ((kt * 4 + s) * 64 + lane) * 16);
            aY = MFMA32(aN, bC, aY); S = MFMA32(aB, bC, S); }
#pragma unroll
        for (int ii = 0; ii < 16; ++ii) LH(YT + ((tt * 32 + crow(ii, hh)) * 72 + vt * 32 + l31) * 2) = f2bf(aY[ii]);
        store_tile_T(lds, SS, 72, kt * 32, vt * 32, S, lane);
        WAIT_VM0();
        __syncthreads();
        if (more) { for (int k = q; k < 16; k += 4) dma_one(lds, BN + k * 1024, gn + 8192 + k * 1024, lane); }
#pragma unroll
        for (int k2 = 0; k2 < 2; ++k2) { const int row = rowA + 32 * k2; float yv[8];
            { const bf16x8 y8 = LV8(YT + (row * 72 + cg * 8) * 2);
#pragma unroll
              for (int k = 0; k < 8; ++k) yv[k] = bf2f((unsigned short)y8[k]); }
            float s1 = 0.f, s2 = 0.f;
#pragma unroll
            for (int k = 0; k < 8; ++k) { s1 += yv[k]; s2 += yv[k] * yv[k]; }
            s1 = row_sum8(s1); s2 = row_sum8(s2);
            const float mean = s1 * (1.f / 64.f); const float var = fmaxf(s2 * (1.f / 64.f) - mean * mean, 0.f); const float rstd = rsqrtf(var + 64e-5f);
            const u32x4 vc = k2 ? vc1 : vc0, vp = k2 ? vp1 : vp0, gc = k2 ? gc1 : gc0, gp = k2 ? gp1 : gp0; const float bon = k2 ? bon1 : bon0;
            const unsigned vcw[4] = {vc.x, vc.y, vc.z, vc.w}, vpw[4] = {vp.x, vp.y, vp.z, vp.w}, gcw[4] = {gc.x, gc.y, gc.z, gc.w}, gpw[4] = {gp.x, gp.y, gp.z, gp.w};
            float ov[8];
#pragma unroll
            for (int k = 0; k < 8; ++k) { const float vcur = (k & 1) ? bfhi(vcw[k >> 1]) : bflo(vcw[k >> 1]), vprv = (k & 1) ? bfhi(vpw[k >> 1]) : bflo(vpw[k >> 1]);
                const float gcur = (k & 1) ? bfhi(gcw[k >> 1]) : bflo(gcw[k >> 1]), gprv = (k & 1) ? bfhi(gpw[k >> 1]) : bflo(gpw[k >> 1]);
                const float vv = vcur + (vprv - vcur) * muv[k], gt = gcur + (gprv - gcur) * mug[k];
                const float gn2 = (yv[k] - mean) * rstd * lnw[k] + lnb[k]; ov[k] = (gn2 + bon * vv) * siluf_(gt); }
            u32x4 w; w.x = pack2(ov[0], ov[1]); w.y = pack2(ov[2], ov[3]); w.z = pack2(ov[4], ov[5]); w.w = pack2(ov[6], ov[7]);
            *(u32x4*)(p->xb + (row0 + 32 * k2) * DM + 512 + cB0) = w; }
        cu0 = nu0; cu1 = nu1; cy0 = ny0; cy1 = ny1; ck0 = nk0; ck1 = nk1;
    }
    if (tid == 0) __hip_atomic_store(p->bar + XCD_BAR_WORDS + 64 * (32 + bhp), (unsigned)((sst + 1) * CPS + 1), __ATOMIC_RELAXED, __HIP_MEMORY_SCOPE_AGENT);
    if (!dry)
#pragma unroll
    for (int ii = 0; ii < 16; ++ii) Sg[(vt * 32 + l31) * 64 + kt * 32 + crow(ii, hh)] = S[ii];
    __syncthreads();
}


DI void scan_helper(int tidx, PARG p, int r, int sst) {
    int tid_ = tidx; asm volatile("" : "+v"(tid_)); const int tid = tid_;
    unsigned* prog = p->bar + XCD_BAR_WORDS + 64 * r;
    for (int nl = 0; nl < CPS; ++nl) {
        if (tid == 0) { const unsigned need = (unsigned)(sst * CPS + nl - 1); unsigned spins = 0;
            while ((int)__hip_atomic_load(prog, __ATOMIC_RELAXED, __HIP_MEMORY_SCOPE_AGENT) < (int)need && ++spins < (1u << 20)) __builtin_amdgcn_s_sleep(4); }
        __syncthreads();
        if (r < 32) { const char* g = (const char*)(p->scanA + ((size_t)r * CPS + nl) * A_UNIT) + tid * 16;
#pragma unroll
            for (int k = 0; k < 9; ++k) { const u32x4 v = *(const u32x4*)(g + k * 8192); asm volatile("" :: "v"(v.x)); }
        } else { const int rb = r - 32, b = rb >> 2, h0 = (rb & 3) * 2;
#pragma unroll
            for (int hs = 0; hs < 2; ++hs) { const char* g = (const char*)(p->scanB + ((size_t)(b * 8 + h0 + hs) * CPS + nl) * B_UNIT) + tid * 16;
#pragma unroll
                for (int k = 0; k < 7; ++k) { const u32x4 v = *(const u32x4*)(g + k * 8192); asm volatile("" :: "v"(v.x)); } }
        }
    }
}

DI void sample_token(int tidx, PARG p, LAS unsigned char* lds, int b) {
    int tid_ = tidx; asm volatile("" : "+v"(tid_)); const int tid = tid_, lane = tid & 63, wid = __builtin_amdgcn_readfirstlane(tid >> 6);
    constexpr int QKV = 0, XBS = 1536 * 4, TWS = 3712 * 4, WDEC = 3776 * 4, ASG = 4288 * 4, KKR = 4800 * 4, KMOD = 5312 * 4, KKS = 5824 * 4, NRM = 6336 * 4, BG = 6344 * 4, BON = 6352 * 4, PART = 6360 * 4;
    const size_t R = NTOK + b; const bf16_t* pr = p->proj + R * NPAD;
#pragma unroll
    for (int m = 0; m < 3; ++m) { const int c = tid + 512 * m; const float* sc = p->state_a_conv + (size_t)b * 3 * 1536 + c; const float s0 = sc[0], s1 = sc[1536], s2 = sc[3072], cur = bf2f(pr[c]);
        const float o = s0 * p->conv_w[c] + s1 * p->conv_w[1536 + c] + s2 * p->conv_w[3072 + c] + cur * p->conv_w[4608 + c];
        LF(QKV + c * 4) = siluf_(o); float* oc = p->s_aconv + (size_t)b * 3 * 1536 + c; oc[0] = s1; oc[1536] = s2; oc[3072] = cur; }
    for (int j = tid; j < BW; j += 512) { const float cur = bf2f(pr[BOFF + j]), prev = p->state_b_shift[(size_t)b * BW + j];
        LF(XBS + j * 4) = cur + (prev - cur) * p->mu[j]; p->s_bshift[(size_t)b * BW + j] = cur; }
    __syncthreads();
    { const int hd = wid & 3, which = wid >> 2; const int o0 = which * 512 + hd * 128 + lane * 2; const float a = LF(QKV + o0 * 4), c = LF(QKV + (o0 + 1) * 4);
      const float ss = wave_sum(a * a + c * c); if (lane == 0) LF(NRM + wid * 4) = rsqrtf(ss + 1e-12f) * (which == 0 ? 0.08838834764831845f : 1.f); }
    if (tid < 4) { LF(BG + tid * 4) = sigmoidf_(bf2f(pr[2048 + tid])); LF(BG + (4 + tid) * 4) = __expf(-__expf(p->a_log[tid]) * softplusf_(bf2f(pr[2052 + tid]) + p->dt_bias[tid])); }
    if (tid < 64) LF(TWS + tid * 4) = tanhf_(LF(XBS + (2048 + tid) * 4));
    __syncthreads();
    { const int cB = tid; float lw = 0.f, la = 0.f;
#pragma unroll 4
      for (int l0 = 0; l0 < 64; l0 += 16) { float wv[16], av[16];
#pragma unroll
          for (int l = 0; l < 16; ++l) { wv[l] = p->w2[(l0 + l) * 512 + cB]; av[l] = p->a2[(l0 + l) * 512 + cB]; }
#pragma unroll
          for (int l = 0; l < 16; ++l) { lw += LF(TWS + (l0 + l) * 4) * wv[l]; la += LF(XBS + (2112 + l0 + l) * 4) * av[l]; } }
      const float a = sigmoidf_(p->a0[cB] + la); const float kr = LF(XBS + (512 + cB) * 4);
      LF(WDEC + cB * 4) = __expf(-0.6065306597126334f * sigmoidf_(p->w0[cB] + lw)); LF(ASG + cB * 4) = a; LF(KKR + cB * 4) = kr * p->k_k[cB]; LF(KMOD + cB * 4) = kr * (1.f + (a - 1.f) * p->k_a[cB]); }
    __syncthreads();
    { const int cB = wid * 64 + lane; const float kv = LF(KKR + cB * 4); const float ss = wave_sum(kv * kv); LF(KKS + cB * 4) = kv * rsqrtf(ss + 1e-12f);
      const float bon = wave_sum(LF(XBS + cB * 4) * LF(KMOD + cB * 4) * p->r_k[cB]); if (lane == 0) LF(BON + wid * 4) = bon; }
    __syncthreads();
    {
        const int hd = tid >> 7, v = tid & 127; const float* S0 = p->state_a_mat + ((size_t)b * 4 + hd) * 16384 + v; float* S1 = p->s_amat + ((size_t)b * 4 + hd) * 16384 + v;
        const float nq = LF(NRM + hd * 4), nk = LF(NRM + (4 + hd) * 4), beta = LF(BG + hd * 4), eg = LF(BG + (4 + hd) * 4);
        float kS = 0.f, qS = 0.f, qk = 0.f;
#pragma unroll 1
        for (int k0 = 0; k0 < 128; k0 += 32) { float sv[32];
#pragma unroll
            for (int k = 0; k < 32; ++k) sv[k] = S0[(k0 + k) * 128];
#pragma unroll
            for (int k = 0; k < 32; ++k) { const float qn = LF(QKV + (hd * 128 + k0 + k) * 4) * nq, kn = LF(QKV + (512 + hd * 128 + k0 + k) * 4) * nk; kS += kn * sv[k]; qS += qn * sv[k]; qk += qn * kn; } }
        const float vval = LF(QKV + (1024 + hd * 128 + v) * 4); const float u = beta * (vval - eg * kS); const float o = eg * qS + qk * u;
#pragma unroll 1
        for (int k0 = 0; k0 < 128; k0 += 32) { float sv[32];
#pragma unroll
            for (int k = 0; k < 32; ++k) sv[k] = S0[(k0 + k) * 128];
#pragma unroll
            for (int k = 0; k < 32; ++k) { const float kn = LF(QKV + (512 + hd * 128 + k0 + k) * 4) * nk; __builtin_nontemporal_store(eg * sv[k] + kn * u, &S1[(k0 + k) * 128]); } }
        const float ss = wave_sum(o * o); if (lane == 0) LF(PART + wid * 4) = ss;
        __syncthreads();
        const float rs = rsqrtf((LF(PART + (2 * hd) * 4) + LF(PART + (2 * hd + 1) * 4)) * (1.f / 128.f) + 1e-6f);
        const float gate = bf2f(pr[1536 + hd * 128 + v]);
        p->xb[R * DM + hd * 128 + v] = f2bf(o * rs * p->a_norm_w[v] * siluf_(gate));
    }
    {
        const int hd = wid, v = lane, cB = hd * 64 + v; const float* S0 = p->state_b_mat + (((size_t)b * 8 + hd) * 64 + v) * 64; float* S1 = p->s_bmat + (((size_t)b * 8 + hd) * 64 + v) * 64;
        f32x4 s[16]; float sa = 0.f;
#pragma unroll
        for (int i = 0; i < 16; ++i) { s[i] = *(const f32x4*)(S0 + 4 * i);
#pragma unroll
            for (int j = 0; j < 4; ++j) sa -= s[i][j] * LF(KKS + (hd * 64 + 4 * i + j) * 4); }
        const float vv = LF(XBS + (1024 + cB) * 4); float y = 0.f;
#pragma unroll
        for (int i = 0; i < 16; ++i) {
#pragma unroll
            for (int j = 0; j < 4; ++j) { const int k = hd * 64 + 4 * i + j; const float sn = s[i][j] * LF(WDEC + k * 4) + sa * (LF(KKS + k * 4) * LF(ASG + k * 4)) + vv * LF(KMOD + k * 4); s[i][j] = sn; y += sn * LF(XBS + k * 4); }
            __builtin_nontemporal_store(s[i], (f32x4*)(S1 + 4 * i)); }
        const float mean = wave_sum(y) * (1.f / 64.f); const float d = y - mean; const float var = wave_sum(d * d) * (1.f / 64.f);
        const float gn = d * rsqrtf(var + 64e-5f) * p->ln_w[cB] + p->ln_b[cB];
        p->xb[R * DM + 512 + cB] = f2bf((gn + LF(BON + hd * 4) * vv) * siluf_(LF(XBS + (1536 + cB) * 4)));
    }
    __syncthreads();
}

DI void prompt_tail_states(int tidx, PARG p, int b) {
    int tid_ = tidx; asm volatile("" : "+v"(tid_));
    for (int e = tid_; e < 3 * 1536; e += 512) { const int i = e / 1536, c = e % 1536; p->p_aconv[(size_t)b * 4608 + e] = bf2f(p->proj[(size_t)(b * SEQ + 2045 + i) * NPAD + c]); }
    for (int j = tid_; j < BW; j += 512) p->p_bshift[(size_t)b * BW + j] = bf2f(p->proj[(size_t)(b * SEQ + 2047) * NPAD + BOFF + j]);
}

DI void final_norm(int tidx, PARG p) {
    int tid_ = tidx; asm volatile("" : "+v"(tid_)); const int lane = tid_ & 63, wid = __builtin_amdgcn_readfirstlane(tid_ >> 6);
    const int stride = gridDim.x * 8; f32x4 fw[4];
#pragma unroll
    for (int i = 0; i < 4; ++i) fw[i] = *(const f32x4*)(p->final_norm_w + i * 256 + lane * 4);
    for (int row0 = blockIdx.x * 8 + wid; row0 < MROWS; row0 += 4 * stride) {
        f32x4 v[4][4]; float ssr[4];
#pragma unroll
        for (int r = 0; r < 4; ++r) { const int row = row0 + r * stride; ssr[r] = 0.f;
            if (row < MROWS) { ssr[r] = lane < 16 ? p->rowss[(size_t)row * 16 + lane] : 0.f; const float* yr = p->y + (size_t)row * DM;
#pragma unroll
                for (int i = 0; i < 4; ++i) v[r][i] = *(const f32x4*)(yr + i * 256 + lane * 4); } }
#pragma unroll
        for (int r = 0; r < 4; ++r) { const int row = row0 + r * stride;
            if (row < MROWS) { const float sc = rsqrtf(wave_sum(ssr[r]) * (1.f / 1024.f) + 1e-6f); float* yr = p->y + (size_t)row * DM;
#pragma unroll
                for (int i = 0; i < 4; ++i) { f32x4 o; o[0] = v[r][i][0] * sc * fw[i][0]; o[1] = v[r][i][1] * sc * fw[i][1]; o[2] = v[r][i][2] * sc * fw[i][2]; o[3] = v[r][i][3] * sc * fw[i][3];
                    __builtin_nontemporal_store(o, (f32x4*)(yr + i * 256 + lane * 4)); } } }
    }
}

#ifdef DBL_SYNC
#define GSYNC1() do { XcdBarrier xb2; xb2.bar = OPAQUE(kp)->bar; xb2.x = xb_xcc_id(); xb2.st = xst; xcd_barrier(xb2, wave_idx == 0 && LANEID == 0); } while (0)
#define GSYNC() do { GSYNC1(); GSYNC1(); } while (0)
#else
#define GSYNC() do { XcdBarrier xb2; xb2.bar = OPAQUE(kp)->bar; xb2.x = xb_xcc_id(); xb2.st = xst; xcd_barrier(xb2, wave_idx == 0 && LANEID == 0); } while (0)
#endif
__global__ void __launch_bounds__(512, 2) hymba_step_megakernel(Params pv) {
    extern __shared__ __attribute__((aligned(16))) unsigned char shm[];
    LAS unsigned char* lds = (LAS unsigned char*)shm;
    cg::grid_group grid = cg::this_grid();
    volatile LAS unsigned* xst = (volatile LAS unsigned*)(lds + LDS_BYTES - 16);
    if (threadIdx.x == 0) { xst[0] = 0u; xst[1] = 0u; xst[2] = 0u; xst[3] = 0u; }
    __syncthreads();
    const int G = gridDim.x, wg = blockIdx.x;
    const int wave_idx = __builtin_amdgcn_readfirstlane(threadIdx.x >> 6);
#define LANEID ({ int l_; asm volatile("v_mbcnt_lo_u32_b32 %0, -1, 0\n\tv_mbcnt_hi_u32_b32 %0, -1, %0" : "=v"(l_)); l_; })
#define TIDX (wave_idx * 64 + LANEID)
    PARG kp = (PARG)__builtin_amdgcn_kernarg_segment_ptr();
    if (__builtin_expect(pv.y == nullptr, 1)) { grid.sync(); return; }
    (void)xcd_barrier_post(pv.bar, xst);

    phase0(TIDX, OPAQUE(kp), lds);
#ifdef DBL_G
    __syncthreads(); phase0(TIDX, OPAQUE(kp), lds);
#endif
    GSYNC();
#ifdef DBL_G
    { PARG p = OPAQUE(kp); pg8::Gemm g; g.A = p->xb; g.Bt = p->winT; g.M = MPAD; g.N = NPAD; g.K = DM;
      pg8::StaticOrder S; S.init(MPAD, NPAD, G, wg); EpiProj E; E.O = p->proj; E.ldc = NPAD;
      pg8::gemm_phase<EpiProj, pg8::StaticOrder, false>(lds, g, S, E, nullptr, TIDX); }
    __syncthreads();
#endif
    { PARG p = OPAQUE(kp); pg8::Gemm g; g.A = p->xb; g.Bt = p->winT; g.M = MPAD; g.N = NPAD; g.K = DM;
      pg8::StaticOrder S; S.init(MPAD, NPAD, G, wg); EpiProj E; E.O = p->proj; E.ldc = NPAD;
      pg8::gemm_phase<EpiProj, pg8::StaticOrder, false>(lds, g, S, E, nullptr, TIDX); }
    GSYNC();
#define P2_QUEUE(t) do { \
        _Pragma("unroll 1") for (;;) { \
            LBAR(); \
            if (TIDX == 0) *(volatile LAS unsigned*)(lds + LDS_BYTES - 32) = __hip_atomic_fetch_add(OPAQUE(kp)->bar + XCD_BAR_WORDS + 4096 + 64 * (t), 1u, __ATOMIC_RELAXED, __HIP_MEMORY_SCOPE_AGENT); \
            LBAR(); \
            const int q_ = (int)*(volatile LAS unsigned*)(lds + LDS_BYTES - 32); \
            if (q_ >= 96 * CPS) break; \
            const int nl_ = q_ / 96, r_ = q_ % 96; const bool isA_ = r_ < 32; const int bhB_ = r_ - 32; \
            const int srole_ = isA_ ? r_ : 32 + (bhB_ >> 3) * 4 + ((bhB_ & 7) >> 1); \
            if ((t) > 0) { if (TIDX == 0) { const int need_ = ((t) - 1) * CPS + nl_ + 2; unsigned sp_ = 0; \
                    while ((int)__hip_atomic_load(OPAQUE(kp)->bar + XCD_BAR_WORDS + 64 * srole_, __ATOMIC_RELAXED, __HIP_MEMORY_SCOPE_AGENT) < need_ && ++sp_ < (1u << 22)) __builtin_amdgcn_s_sleep(4); } \
                __syncthreads(); } \
            if (isA_) p2a_unit(TIDX, OPAQUE(kp), lds, r_ >> 2, r_ & 3, (t) * CPS + nl_, r_ * CPS + nl_); \
            else p2b_unit(TIDX, OPAQUE(kp), lds, bhB_ >> 3, bhB_ & 7, (t) * CPS + nl_, bhB_ * CPS + nl_); \
        } } while (0)
    P2_QUEUE(0);
    GSYNC();
#pragma unroll 1
    for (int sst = 0; sst < NSUPER; ++sst) {
        const bool helpers = false;
        const int nscan = 64, nsmp = sst == 0 ? 48 : (sst < 3 ? 40 : 0), tokb = sst == 0 ? 0 : (sst == 1 ? 48 : 88); const int nhelp = helpers ? 64 : 0; const int nroles = nscan + nsmp + nhelp + (sst == 3 ? 4 : 0);
#pragma unroll 1
        for (int role = wg; role < nroles; role += G) {
            if (role < 32) scanA(TIDX, OPAQUE(kp), lds, role, sst);
            else if (role < 64) scanB(TIDX, OPAQUE(kp), lds, role - 32, sst);
            else if (role < nscan + nsmp) { const int sb = tokb + role - 64; sample_token(TIDX, OPAQUE(kp), lds, sb); if (sb < 8) prompt_tail_states(TIDX, OPAQUE(kp), sb); }
            else if (role < nscan + nsmp + nhelp) scan_helper(TIDX, OPAQUE(kp), role - nscan - nsmp, sst);
            else {
                PARG p = OPAQUE(kp); pg8::Gemm g; g.A = p->xb; g.Bt = p->woutT; g.M = MPAD; g.N = DM; g.K = DM;
                OneUnit S1; S1.pm = 64; S1.pn = role - (nscan + nsmp + nhelp); EpiOut E; E.xp = p->x_prompt; E.xs = p->x_sample; E.out = p->y; E.rowss = p->rowss;
                pg8::gemm_phase<EpiOut, OneUnit, false>(lds, g, S1, E, nullptr, TIDX); }
        }
        if (sst + 1 < NSUPER) P2_QUEUE(sst + 1);
        GSYNC();
    }
#ifdef DBL_G
    { PARG p = OPAQUE(kp); pg8::Gemm g; g.A = p->xb; g.Bt = p->woutT; g.M = MPAD; g.N = DM; g.K = DM;
      pg8::StaticOrder S; S.init(NTOK, DM, G, wg); EpiOut E; E.xp = p->x_prompt; E.xs = p->x_sample; E.out = p->y; E.rowss = p->rowss;
      pg8::gemm_phase<EpiOut, pg8::StaticOrder, false>(lds, g, S, E, nullptr, TIDX); }
    __syncthreads();
#endif
    { PARG p = OPAQUE(kp); pg8::Gemm g; g.A = p->xb; g.Bt = p->woutT; g.M = MPAD; g.N = DM; g.K = DM;
      pg8::StaticOrder S; S.init(NTOK, DM, G, wg); EpiOut E; E.xp = p->x_prompt; E.xs = p->x_sample; E.out = p->y; E.rowss = p->rowss;
      pg8::gemm_phase<EpiOut, pg8::StaticOrder, false>(lds, g, S, E, nullptr, TIDX); }
    GSYNC();
    final_norm(TIDX, OPAQUE(kp));
}

extern "C" void kernel_launch(void* const* d_in, const int* in_sizes, int n_in, void* d_out, int out_size, void* d_ws, size_t ws_size, hipStream_t stream) {
    (void)in_sizes; (void)n_in; (void)out_size; (void)ws_size;
    static int grid_blocks = 0;
    if (!grid_blocks) {
        int dev = 0, cus = 0, per_cu = 0;
        hipGetDevice(&dev);
        hipDeviceGetAttribute(&cus, hipDeviceAttributeMultiprocessorCount, dev);
        if (hipFuncSetAttribute((const void*)hymba_step_megakernel, hipFuncAttributeMaxDynamicSharedMemorySize, LDS_BYTES) != hipSuccess) fprintf(stderr, "hipFuncSetAttribute failed\n");
        if (hipOccupancyMaxActiveBlocksPerMultiprocessor(&per_cu, (const void*)hymba_step_megakernel, 512, LDS_BYTES) != hipSuccess || per_cu < 1) per_cu = 1;
        grid_blocks = cus * per_cu; if (grid_blocks > 256) grid_blocks = 256;
    }
    Params p{};
    const float* const* in = (const float* const*)d_in;
    p.x_prompt = in[0]; p.x_sample = in[1]; p.state_a_mat = in[2]; p.state_a_conv = in[3]; p.state_b_mat = in[4]; p.state_b_shift = in[5];
    p.norm_w = in[6]; p.w_in = in[7]; p.conv_w = in[8]; p.a_log = in[9]; p.dt_bias = in[10]; p.a_norm_w = in[11]; p.mu = in[12]; p.w0 = in[13]; p.w2 = in[14];
    p.a0 = in[15]; p.a2 = in[16]; p.k_k = in[17]; p.k_a = in[18]; p.r_k = in[19]; p.ln_w = in[20]; p.ln_b = in[21]; p.w_out = in[22]; p.final_norm_w = in[23];
    float* o = (float*)d_out;
    p.y = o; o += (size_t)MROWS * DM;
    p.p_amat = o; o += 8 * 4 * 128 * 128; p.p_aconv = o; o += 8 * 3 * 1536; p.p_bmat = o; o += 8 * 8 * 64 * 64; p.p_bshift = o; o += 8 * BW;
    p.s_amat = o; o += (size_t)128 * 4 * 128 * 128; p.s_aconv = o; o += 128 * 3 * 1536; p.s_bmat = o; o += (size_t)128 * 8 * 64 * 64; p.s_bshift = o;
    unsigned char* w = (unsigned char*)d_ws; size_t off = 0;
    auto take = [&](size_t bytes) { unsigned char* r = w + off; off += (bytes + 255) & ~(size_t)255; return r; };
    p.xb = (bf16_t*)take((size_t)MPAD * DM * 2); p.winT = (bf16_t*)take((size_t)NPAD * DM * 2); p.woutT = (bf16_t*)take((size_t)DM * DM * 2);
    p.proj = (bf16_t*)take((size_t)MPAD * NPAD * 2);
    p.scanA = (bf16_t*)take((size_t)32 * CPS * A_UNIT * 2); p.scanB = (bf16_t*)take((size_t)64 * CPS * B_UNIT * 2);
    p.glast = (float*)take(32 * CPS * 4); p.ptb = (float*)take((size_t)64 * CPS * 64 * 4); p.bonus = (float*)take((size_t)NTOK * 8 * 4); p.rowss = (float*)take((size_t)MPAD * 16 * 4);
    p.bar = (unsigned*)take((XCD_BAR_WORDS + 4096 + 8 * 64) * 4);
    hipMemsetAsync(p.bar, 0, (XCD_BAR_WORDS + 4096 + 8 * 64) * 4, stream);
    void* args[] = {&p};
    hipError_t e = hipLaunchCooperativeKernel((const void*)hymba_step_megakernel, dim3(grid_blocks), dim3(512), args, LDS_BYTES, stream);
    if (e != hipSuccess) fprintf(stderr, "cooperative launch failed: %s (grid %d)\n", hipGetErrorString(e), grid_blocks);
}
```
